# Optimizing an MI355X kernel written in HIP

```python
import math
import jax, jax.numpy as jnp
from jax import lax
import numpy as np

D_MODEL = 1024
BATCH = 1
SEQ = 16384
DEPTH = 1

D_MIX = D_MODEL
D_MLSTM = D_MIX // 2
N_MLSTM_HEADS = 4
MLSTM_HEAD_DIM = D_MLSTM // N_MLSTM_HEADS
CHUNK = 64
CONV_WIDTH = 4
D_SSM = D_MIX - D_MLSTM
SSM_GROUP = 16
N_SSM_GROUPS = D_SSM // SSM_GROUP
SSM_STATE = 64
D_FF = 4 * D_MODEL
EPS = 1e-6
DT_MIN = 1e-3
DT_MAX = 1e-1
IN_COLS = 4 * D_MLSTM + 2 * N_MLSTM_HEADS + D_SSM

kernel_name = 'hymba_mlstm_s5_hybrid_block'


def rmsnorm(x, g):
    xf = x.astype(jnp.float32)
    r = lax.rsqrt(jnp.mean(xf * xf, axis=-1, keepdims=True) + EPS)
    return (xf * r * g.astype(jnp.float32)).astype(x.dtype)


def causal_depthwise_conv(x, w, b):
    S = x.shape[1]
    xp = jnp.pad(x, ((0, 0), (CONV_WIDTH - 1, 0), (0, 0)))
    out = b
    for j in range(CONV_WIDTH):
        out = out + xp[:, j:j + S, :] * w[j]
    return out


def headwise_layernorm(h, w):
    mu = jnp.mean(h, axis=-1, keepdims=True)
    var = jnp.mean(jnp.square(h - mu), axis=-1, keepdims=True)
    hn = (h - mu) * lax.rsqrt(var + EPS)
    Bsz, S, H, D = h.shape
    return hn.reshape(Bsz, S, H * D) * w.astype(jnp.float32)


def mlstm_chunkwise(q, k, v, i_pre, f_pre):
    Bsz, S, H, D = q.shape
    NC, L = S // CHUNK, CHUNK

    def to_chunks(t):
        return t.reshape(Bsz, NC, L, H, D).transpose(0, 3, 1, 2, 4)

    q = to_chunks(q) * (D ** -0.5)
    k = to_chunks(k)
    v = to_chunks(v)
    log_f = jax.nn.log_sigmoid(f_pre).reshape(Bsz, NC, L, H).transpose(0, 3, 1, 2)
    log_i = i_pre.reshape(Bsz, NC, L, H).transpose(0, 3, 1, 2)
    b = jnp.cumsum(log_f, axis=-1)
    b_last = b[..., -1]

    causal = jnp.tril(jnp.ones((L, L), dtype=bool))
    log_d = jnp.where(causal, b[..., :, None] - b[..., None, :] + log_i[..., None, :], -jnp.inf)

    g = b_last[..., None] - b + log_i
    a = jnp.max(g, axis=-1)
    w_g = jnp.exp(g - a[..., None])
    C_loc = jnp.einsum('bhcl,bhcld,bhcle->bhcde', w_g, v, k)
    n_loc = jnp.einsum('bhcl,bhcle->bhce', w_g, k)

    def step(carry, inp):
        C, n, m = carry
        bl, a_c, Cl, nl = inp
        m_new = jnp.maximum(bl + m, a_c)
        s_old = jnp.exp(bl + m - m_new)
        s_new = jnp.exp(a_c - m_new)
        C_new = s_old[..., None, None] * C + s_new[..., None, None] * Cl
        n_new = s_old[..., None] * n + s_new[..., None] * nl
        return (C_new, n_new, m_new), (C, n, m)

    init = (jnp.zeros((Bsz, H, D, D), jnp.float32),
            jnp.zeros((Bsz, H, D), jnp.float32),
            jnp.zeros((Bsz, H), jnp.float32))
    xs = (jnp.moveaxis(b_last, 2, 0), jnp.moveaxis(a, 2, 0),
          jnp.moveaxis(C_loc, 2, 0), jnp.moveaxis(n_loc, 2, 0))
    _, (C_prev, n_prev, m_prev) = lax.scan(step, init, xs)
    C_prev = jnp.moveaxis(C_prev, 0, 2)
    n_prev = jnp.moveaxis(n_prev, 0, 2)
    m_prev = jnp.moveaxis(m_prev, 0, 2)

    inter_log = b + m_prev[..., None]
    m_t = jnp.maximum(inter_log, jnp.max(log_d, axis=-1))
    inter_scale = jnp.exp(inter_log - m_t)
    d_mat = jnp.exp(log_d - m_t[..., None])
    s_qk = jnp.einsum('bhcld,bhcsd->bhcls', q, k) * d_mat
    num = (inter_scale[..., None] * jnp.einsum('bhcde,bhcle->bhcld', C_prev, q)
           + jnp.einsum('bhcls,bhcsd->bhcld', s_qk, v))
    den = inter_scale * jnp.einsum('bhce,bhcle->bhcl', n_prev, q) + jnp.sum(s_qk, axis=-1)
    h = num / jnp.maximum(jnp.abs(den), jnp.exp(-m_t))[..., None]
    return h.transpose(0, 2, 3, 1, 4).reshape(Bsz, S, H, D)


def s5_groups(u, lam_re, lam_im, log_dt, b_re, b_im, c_re, c_im, d):
    f32 = jnp.float32
    lam = lax.complex(lam_re.astype(f32), lam_im.astype(f32))
    dt = jnp.exp(log_dt.astype(f32))[:, None]
    lam_bar = jnp.exp(lam * dt)
    Bc = lax.complex(b_re.astype(f32), b_im.astype(f32))
    B_bar = ((lam_bar - 1.0) / lam)[..., None] * Bc
    Cc = lax.complex(c_re.astype(f32), c_im.astype(f32))
    Bu = jnp.einsum('gpc,bsgc->bsgp', B_bar, u.astype(jnp.complex64))
    A_elems = jnp.broadcast_to(lam_bar, Bu.shape)

    def combine(left, right):
        a_l, x_l = left
        a_r, x_r = right
        return a_r * a_l, a_r * x_l + x_r

    _, states = lax.associative_scan(combine, (A_elems, Bu), axis=1)
    y = jnp.einsum('gcp,bsgp->bsgc', Cc, states).real
    return y + d.astype(f32) * u


def hybrid_mixer(h, w_in, conv_w, conv_b, i_bias, f_bias, mlstm_norm_w,
                 lam_re, lam_im, log_dt, b_re, b_im, c_re, c_im, ssm_d,
                 glu_w, glu_b, w_out):
    Bsz, S, _ = h.shape
    f32 = jnp.float32
    proj = h @ w_in
    qk_pre = proj[..., :2 * D_MLSTM]
    v = proj[..., 2 * D_MLSTM:3 * D_MLSTM]
    o_pre = proj[..., 3 * D_MLSTM:4 * D_MLSTM]
    gates = proj[..., 4 * D_MLSTM:4 * D_MLSTM + 2 * N_MLSTM_HEADS]
    u = proj[..., 4 * D_MLSTM + 2 * N_MLSTM_HEADS:]

    qk = jax.nn.silu(causal_depthwise_conv(qk_pre, conv_w, conv_b)).astype(f32)
    heads = lambda t: t.reshape(Bsz, S, N_MLSTM_HEADS, MLSTM_HEAD_DIM)
    q = heads(qk[..., :D_MLSTM])
    k = heads(qk[..., D_MLSTM:])
    vh = heads(v.astype(f32))
    gates = gates.astype(f32)
    i_pre = gates[..., :N_MLSTM_HEADS] + i_bias.astype(f32)
    f_pre = gates[..., N_MLSTM_HEADS:] + f_bias.astype(f32)
    h_m = mlstm_chunkwise(q, k, vh, i_pre, f_pre)
    h_m = headwise_layernorm(h_m, mlstm_norm_w) * jax.nn.sigmoid(o_pre.astype(f32))

    ug = u.astype(f32).reshape(Bsz, S, N_SSM_GROUPS, SSM_GROUP)
    y = s5_groups(ug, lam_re, lam_im, log_dt, b_re, b_im, c_re, c_im,
                  ssm_d.reshape(N_SSM_GROUPS, SSM_GROUP)).reshape(Bsz, S, D_SSM)
    z = jax.nn.gelu(y)
    y = z * jax.nn.sigmoid(z @ glu_w.astype(f32) + glu_b.astype(f32))

    mixed = jnp.concatenate([h_m, y], axis=-1).astype(h.dtype)
    return mixed @ w_out


def squared_relu_mlp(h, w_ff1, w_ff2):
    a = jax.nn.relu(h @ w_ff1)
    return (a * a) @ w_ff2


def setup_inputs(seed: int = 0) -> dict:
    key = jax.random.key(seed)
    ks = jax.random.split(key, 24)
    f32 = jnp.float32
    nrm = lambda k, shape, s: jax.random.normal(k, shape, f32) * s
    x = jax.random.normal(ks[0], (BATCH, SEQ, D_MODEL), f32)
    mix_norm_w = 1.0 + nrm(ks[1], (DEPTH, D_MODEL), 0.02)
    w_in = nrm(ks[2], (DEPTH, D_MODEL, IN_COLS), D_MODEL ** -0.5)
    conv_w = nrm(ks[3], (DEPTH, CONV_WIDTH, 2 * D_MLSTM), CONV_WIDTH ** -0.5)
    conv_b = nrm(ks[4], (DEPTH, 2 * D_MLSTM), 0.02)
    i_bias = nrm(ks[5], (DEPTH, N_MLSTM_HEADS), 0.1)
    f_bias = jnp.linspace(3.0, 6.0, N_MLSTM_HEADS, dtype=f32)[None, :] + nrm(ks[6], (DEPTH, N_MLSTM_HEADS), 0.01)
    mlstm_norm_w = 1.0 + nrm(ks[7], (DEPTH, D_MLSTM), 0.02)
    ssm_lam_re = -0.5 + nrm(ks[8], (DEPTH, N_SSM_GROUPS, SSM_STATE), 0.01)
    ssm_lam_im = (jnp.pi * jnp.arange(SSM_STATE, dtype=f32))[None, None, :] + nrm(ks[9], (DEPTH, N_SSM_GROUPS, SSM_STATE), 0.01)
    ssm_log_dt = jax.random.uniform(ks[10], (DEPTH, N_SSM_GROUPS), f32, math.log(DT_MIN), math.log(DT_MAX))
    b_scale = (2.0 * SSM_GROUP) ** -0.5
    ssm_b_re = nrm(ks[11], (DEPTH, N_SSM_GROUPS, SSM_STATE, SSM_GROUP), b_scale)
    ssm_b_im = nrm(ks[12], (DEPTH, N_SSM_GROUPS, SSM_STATE, SSM_GROUP), b_scale)
    c_scale = SSM_STATE ** -0.5
    ssm_c_re = nrm(ks[13], (DEPTH, N_SSM_GROUPS, SSM_GROUP, SSM_STATE), c_scale)
    ssm_c_im = nrm(ks[14], (DEPTH, N_SSM_GROUPS, SSM_GROUP, SSM_STATE), c_scale)
    ssm_d = nrm(ks[15], (DEPTH, D_SSM), 1.0)
    glu_w = nrm(ks[16], (DEPTH, D_SSM, D_SSM), D_SSM ** -0.5)
    glu_b = nrm(ks[17], (DEPTH, D_SSM), 0.02)
    w_out = nrm(ks[18], (DEPTH, D_MIX, D_MODEL), D_MIX ** -0.5)
    mlp_norm_w = 1.0 + nrm(ks[19], (DEPTH, D_MODEL), 0.02)
    w_ff1 = nrm(ks[20], (DEPTH, D_MODEL, D_FF), D_MODEL ** -0.5)
    w_ff2 = nrm(ks[21], (DEPTH, D_FF, D_MODEL), D_FF ** -0.5)
    final_norm_w = 1.0 + nrm(ks[22], (D_MODEL,), 0.02)
    return {'x': x, 'mix_norm_w': mix_norm_w, 'w_in': w_in, 'conv_w': conv_w, 'conv_b': conv_b,
            'i_bias': i_bias, 'f_bias': f_bias, 'mlstm_norm_w': mlstm_norm_w,
            'ssm_lam_re': ssm_lam_re, 'ssm_lam_im': ssm_lam_im, 'ssm_log_dt': ssm_log_dt,
            'ssm_b_re': ssm_b_re, 'ssm_b_im': ssm_b_im, 'ssm_c_re': ssm_c_re, 'ssm_c_im': ssm_c_im,
            'ssm_d': ssm_d, 'glu_w': glu_w, 'glu_b': glu_b, 'w_out': w_out,
            'mlp_norm_w': mlp_norm_w, 'w_ff1': w_ff1, 'w_ff2': w_ff2, 'final_norm_w': final_norm_w}


def reference(x, mix_norm_w, w_in, conv_w, conv_b, i_bias, f_bias, mlstm_norm_w,
              ssm_lam_re, ssm_lam_im, ssm_log_dt, ssm_b_re, ssm_b_im, ssm_c_re, ssm_c_im,
              ssm_d, glu_w, glu_b, w_out, mlp_norm_w, w_ff1, w_ff2, final_norm_w):
    for l in range(DEPTH):
        h = rmsnorm(x, mix_norm_w[l])
        x = x + hybrid_mixer(h, w_in[l], conv_w[l], conv_b[l], i_bias[l], f_bias[l], mlstm_norm_w[l],
                             ssm_lam_re[l], ssm_lam_im[l], ssm_log_dt[l], ssm_b_re[l], ssm_b_im[l],
                             ssm_c_re[l], ssm_c_im[l], ssm_d[l], glu_w[l], glu_b[l], w_out[l])
        h = rmsnorm(x, mlp_norm_w[l])
        x = x + squared_relu_mlp(h, w_ff1[l], w_ff2[l])
    return rmsnorm(x, final_norm_w)
```

```cpp
#include <hip/hip_runtime.h>
#include <hip/hip_cooperative_groups.h>
#include <cstdio>
#include <cstdint>
namespace cg = cooperative_groups;
namespace pg8 {
#define PG8_LAS __attribute__((address_space(3)))
typedef unsigned short bf16_t;
typedef short bf16x8 __attribute__((ext_vector_type(8)));
typedef float f32x4 __attribute__((ext_vector_type(4)));
typedef unsigned u32x4 __attribute__((ext_vector_type(4)));
constexpr int BM = 256, BK = 64, HALF = 128, HTB = HALF * BK * 2  , STAGE_BYTES = 8 * HTB, NXCD = 8, WGM = 8;

__host__ __device__ __forceinline__ int lds_byte(int r, int c) { const int st = (r >> 4) * 2 + (c >> 5), rr = r & 15, cc = c & 31, ob = rr * 64 + cc * 2; return st * 1024 + (ob ^ (((ob >> 9) & 1) << 5)); }
__host__ __device__ __forceinline__ void stage_rc(int b, int& R, int& C) { const int st = b / 1024, sb = b % 1024, swz = sb ^ (((sb >> 9) & 1) << 5); R = (st >> 1) * 16 + swz / 64; C = (st & 1) * 32 + (swz % 64) / 2; }
__host__ __device__ __forceinline__ int perm32(int rho) { const int n = rho >> 4, i = rho & 15; return 8 * (i >> 2) + 4 * n + (i & 3); }

struct Unit { int pm, pn; };
struct Gemm { const bf16_t* A; const bf16_t* Bt; int M, N, K; };

struct StaticOrder {
    int nM, nN, nwg, G, c;
    __host__ __device__ void init(int M, int N, int G_, int c_) { nM = M / BM; nN = N / BM; nwg = nM * nN; G = G_; c = c_; }
    __host__ __device__ bool next(int i, Unit& u) const {
        const long L = (long)i * G + c; if (L >= nwg) return false;
        int wgid = (int)L; { const int q = nwg / NXCD, r = nwg % NXCD, xcd = wgid % NXCD, off = wgid / NXCD; wgid = (xcd < r ? xcd * (q + 1) : r * (q + 1) + (xcd - r) * q) + off; }
        const int nig = WGM * nN, gid = wgid / nig, fm = gid * WGM, gsz = (nM - fm) < WGM ? (nM - fm) : WGM;
        u.pm = fm + ((wgid % nig) % gsz); u.pn = (wgid % nig) / gsz; return true;
    }
    __device__ __forceinline__ void a_ready(const Unit&) const {}
    __device__ __forceinline__ void done(const Unit&) const {}
};

__device__ __forceinline__ unsigned cvt_pk_bf16(float lo, float hi) { unsigned r; asm volatile("v_cvt_pk_bf16_f32 %0, %1, %2" : "=v"(r) : "v"(lo), "v"(hi)); return r; }
typedef float f32x2 __attribute__((ext_vector_type(2)));

template <class Epi, class Sched, bool ALIGN_EPI = false, bool SP2 = false>
__device__ __forceinline__ void gemm_phase(PG8_LAS unsigned char* lds, const Gemm g, const Sched& S, const Epi& E) {
    const int tid = threadIdx.x, wid = __builtin_amdgcn_readfirstlane(tid >> 6), lane = tid & 63, wr = wid >> 2, wc = wid & 3, fr = lane & 15, fq = lane >> 4;
    const int K = g.K, nt = K / BK;
    unsigned voffA[2], voffB[2];
#pragma unroll
    for (int i = 0; i < 2; ++i) { int R, C; stage_rc(tid * 16 + i * 8192, R, C); const int Rb = Epi::PERM ? ((R & ~31) + perm32(R & 31)) : R;
        voffA[i] = (unsigned)(R * K + C) * 2u; voffB[i] = (unsigned)(Rb * K + C) * 2u; }
    const size_t kstep = (size_t)(BK * 2);
    const size_t hstep = (size_t)HALF * K * 2;
    const size_t tstep = 2 * hstep;
    const unsigned ldsw = (unsigned)wid * 1024u;
    const int aoff = lds_byte(wr * 64 + fr, fq * 8), boff = lds_byte(wc * 32 + fr, fq * 8);
#define PG8_SA(b, h) (((b) * 2 + (h)) * HTB)
#define PG8_SB(b, h) ((4 + (b) * 2 + (h)) * HTB)
#define PG8_STAGE(bufoff, gbase, voff) do { _Pragma("unroll") for (int _i = 0; _i < 2; ++_i) \
        __builtin_amdgcn_global_load_lds((const unsigned*)((const char*)(gbase) + (voff)[_i]), (PG8_LAS unsigned*)(lds + (bufoff) + ldsw + _i * 8192), 16, 0, 0); } while (0)
#define PG8_LDA(dst, b, h) do { _Pragma("unroll") for (int m = 0; m < 4; ++m) _Pragma("unroll") for (int k = 0; k < 2; ++k) dst[m][k] = *(const PG8_LAS bf16x8*)(lds + PG8_SA(b, h) + aoff + m * 2048 + k * 1024); } while (0)
#define PG8_LDB(dst, b, h) do { _Pragma("unroll") for (int n = 0; n < 2; ++n) _Pragma("unroll") for (int k = 0; k < 2; ++k) dst[n][k] = *(const PG8_LAS bf16x8*)(lds + PG8_SB(b, h) + boff + n * 2048 + k * 1024); } while (0)
#define PG8_MMA(ai, bj, At, Bt) do { __builtin_amdgcn_s_setprio(1); _Pragma("unroll") for (int m = 0; m < 4; ++m) _Pragma("unroll") for (int n = 0; n < 2; ++n) _Pragma("unroll") for (int k = 0; k < 2; ++k) \
        acc[ai][bj][m][n] = __builtin_amdgcn_mfma_f32_16x16x32_bf16(Bt[n][k], At[m][k], acc[ai][bj][m][n], 0, 0, 0); __builtin_amdgcn_s_setprio(0); } while (0)
#define PG8_WAIT_V(n) asm volatile("s_waitcnt vmcnt(" #n ")" ::: "memory")
#define PG8_WAIT_L(n) asm volatile("s_waitcnt lgkmcnt(" #n ")" ::: "memory")
#define PG8_BAR __builtin_amdgcn_s_barrier()
#define PG8_SCHED __builtin_amdgcn_sched_barrier(0)
    Unit cur, nxt; int ui = 0;
    if (!S.next(0, cur)) return;
    f32x4 acc[2][2][4][2];
#pragma unroll
    for (int a = 0; a < 2; ++a)
#pragma unroll
        for (int b = 0; b < 2; ++b)
#pragma unroll
            for (int m = 0; m < 4; ++m)
#pragma unroll
                for (int n = 0; n < 2; ++n) acc[a][b][m][n] = (f32x4){0.f, 0.f, 0.f, 0.f};
    bf16x8 At[4][2], B0[2][2], B1[2][2];
    const char* cA = (const char*)g.A + (size_t)cur.pm * tstep; const char* cB = (const char*)g.Bt + (size_t)cur.pn * tstep;
    S.a_ready(cur);
    if constexpr (SP2) {
        PG8_STAGE(PG8_SB(0, 0), cB, voffB); PG8_STAGE(PG8_SB(0, 1), cB + hstep, voffB); PG8_STAGE(PG8_SA(0, 0), cA, voffA); PG8_STAGE(PG8_SA(0, 1), cA + hstep, voffA);
        if (wr == 1) PG8_BAR;
        PG8_WAIT_V(2); PG8_BAR;
        PG8_STAGE(PG8_SB(1, 0), cB + kstep, voffB); PG8_STAGE(PG8_SA(1, 0), cA + kstep, voffA); PG8_STAGE(PG8_SB(1, 1), cB + hstep + kstep, voffB);
        PG8_WAIT_V(6); PG8_BAR;
    } else {
        PG8_STAGE(PG8_SB(0, 0), cB, voffB); PG8_STAGE(PG8_SA(0, 0), cA, voffA); PG8_STAGE(PG8_SB(0, 1), cB + hstep, voffB); PG8_STAGE(PG8_SA(0, 1), cA + hstep, voffA);
        if (wr == 1) PG8_BAR;
        PG8_WAIT_V(4); PG8_BAR;
        PG8_STAGE(PG8_SB(1, 0), cB + kstep, voffB); PG8_STAGE(PG8_SA(1, 0), cA + kstep, voffA); PG8_STAGE(PG8_SB(1, 1), cB + hstep + kstep, voffB);
        PG8_WAIT_V(6); PG8_BAR;
    }
    for (;;) {
        const bool has_next = S.next(ui + 1, nxt);
        const char* nA = has_next ? (const char*)g.A + (size_t)nxt.pm * tstep : cA; const char* nB = has_next ? (const char*)g.Bt + (size_t)nxt.pn * tstep : cB;
        for (int t = 0; t < nt; t += 2) {
            const bool last = (t == nt - 2);
            const char* a1 = cA + (size_t)(t + 1) * kstep;
            const char* a2 = last ? nA : cA + (size_t)(t + 2) * kstep; const char* b2 = last ? nB : cB + (size_t)(t + 2) * kstep;
            const char* a3 = a2 + kstep; const char* b3 = b2 + kstep;
            if (last && has_next) S.a_ready(nxt);
            if constexpr (SP2) {
            PG8_LDB(B0, 0, 0); PG8_LDB(B1, 0, 1); PG8_SCHED; PG8_LDA(At, 0, 0); PG8_STAGE(PG8_SA(1, 1), a1 + hstep, voffA);
            PG8_WAIT_V(8); PG8_WAIT_L(0); PG8_BAR; PG8_MMA(0, 0, At, B0); PG8_MMA(0, 1, At, B1); PG8_BAR; PG8_SCHED;
            PG8_LDA(At, 0, 1); PG8_STAGE(PG8_SB(0, 0), b2, voffB); PG8_STAGE(PG8_SB(0, 1), b2 + hstep, voffB); PG8_STAGE(PG8_SA(0, 0), a2, voffA);
            PG8_WAIT_V(8); PG8_WAIT_L(0); PG8_BAR; PG8_MMA(1, 0, At, B0); PG8_MMA(1, 1, At, B1); PG8_BAR; PG8_SCHED;
            PG8_LDB(B0, 1, 0); PG8_LDB(B1, 1, 1); PG8_SCHED; PG8_LDA(At, 1, 0); PG8_STAGE(PG8_SA(0, 1), a2 + hstep, voffA);
            PG8_WAIT_V(8); PG8_WAIT_L(0); PG8_BAR; PG8_MMA(0, 0, At, B0); PG8_MMA(0, 1, At, B1); PG8_BAR; PG8_SCHED;
            PG8_LDA(At, 1, 1); PG8_STAGE(PG8_SB(1, 0), b3, voffB); PG8_STAGE(PG8_SB(1, 1), b3 + hstep, voffB); PG8_STAGE(PG8_SA(1, 0), a3, voffA);
            PG8_WAIT_V(8); PG8_WAIT_L(0); PG8_BAR; PG8_MMA(1, 0, At, B0); PG8_MMA(1, 1, At, B1); PG8_BAR; PG8_SCHED;
            } else {
            PG8_LDB(B0, 0, 0); PG8_SCHED; PG8_LDA(At, 0, 0); PG8_STAGE(PG8_SA(1, 1), a1 + hstep, voffA);
            PG8_WAIT_L(8); PG8_BAR; PG8_WAIT_L(0); PG8_MMA(0, 0, At, B0); PG8_BAR; PG8_SCHED;
            PG8_LDB(B1, 0, 1); PG8_STAGE(PG8_SB(0, 0), b2, voffB);
            PG8_BAR; PG8_WAIT_L(0); PG8_MMA(0, 1, At, B1); PG8_BAR;
            PG8_LDA(At, 0, 1); PG8_STAGE(PG8_SA(0, 0), a2, voffA);
            PG8_BAR; PG8_WAIT_L(0); PG8_MMA(1, 0, At, B0); PG8_BAR; PG8_SCHED;
            PG8_STAGE(PG8_SB(0, 1), b2 + hstep, voffB);
            PG8_WAIT_V(6); PG8_BAR; PG8_MMA(1, 1, At, B1); PG8_BAR;
            PG8_LDB(B0, 1, 0); PG8_SCHED; PG8_LDA(At, 1, 0); PG8_STAGE(PG8_SA(0, 1), a2 + hstep, voffA);
            PG8_WAIT_L(8); PG8_BAR; PG8_WAIT_L(0); PG8_MMA(0, 0, At, B0); PG8_BAR; PG8_SCHED;
            PG8_LDB(B1, 1, 1); PG8_STAGE(PG8_SB(1, 0), b3, voffB);
            PG8_BAR; PG8_WAIT_L(0); PG8_MMA(0, 1, At, B1); PG8_BAR;
            PG8_LDA(At, 1, 1); PG8_STAGE(PG8_SA(1, 0), a3, voffA);
            PG8_BAR; PG8_WAIT_L(0); PG8_MMA(1, 0, At, B0); PG8_BAR; PG8_SCHED;
            PG8_STAGE(PG8_SB(1, 1), b3 + hstep, voffB);
            PG8_WAIT_V(6); PG8_BAR; PG8_MMA(1, 1, At, B1); PG8_BAR;
            }
        }
        if constexpr (ALIGN_EPI) { if (wr == 0) PG8_BAR; }
        if constexpr (!Epi::AFTER_DRAIN) { E(acc, cur, wr, wc, fr, fq); S.done(cur); }
        if (!has_next) break;
#pragma unroll
        for (int a = 0; a < 2; ++a)
#pragma unroll
            for (int b = 0; b < 2; ++b)
#pragma unroll
                for (int m = 0; m < 4; ++m)
#pragma unroll
                    for (int n = 0; n < 2; ++n) acc[a][b][m][n] = (f32x4){0.f, 0.f, 0.f, 0.f};
        cur = nxt; cA = nA; cB = nB; ++ui;
        if constexpr (ALIGN_EPI) { if (wr == 1) PG8_BAR; }
    }
    PG8_WAIT_V(0);
    if constexpr (!ALIGN_EPI) { if (wr == 0) PG8_BAR; }
    PG8_BAR;
    if constexpr (Epi::AFTER_DRAIN) { E.fused(acc, cur, wr, wc, fr, fq, lds, wid, lane); S.done(cur); }
#undef PG8_SA
#undef PG8_SB
#undef PG8_STAGE
#undef PG8_LDA
#undef PG8_LDB
#undef PG8_MMA
#undef PG8_WAIT_V
#undef PG8_WAIT_L
#undef PG8_BAR
#undef PG8_SCHED
}
}

#ifndef MK_N_LAUNCHES
#define MK_N_LAUNCHES 1
#endif
#define LAS __attribute__((address_space(3)))
typedef unsigned short bf16;
typedef unsigned v4u __attribute__((ext_vector_type(4)));
typedef unsigned v2u __attribute__((ext_vector_type(2)));
typedef float f32x4 __attribute__((ext_vector_type(4)));
typedef float f32x2v __attribute__((ext_vector_type(2)));
typedef short bf16x8 __attribute__((ext_vector_type(8)));

constexpr int SEQ = 16384, DM = 1024, NPJ = 2560, DFF = 4096, NCHUNK = 256, NPHASE = 10;
constexpr int INW = 2568;
constexpr float EPS = 1e-6f;
constexpr size_t MiB = 1u << 20;
constexpr size_t WS_WIN = 2 * MiB, WS_WGLU = 7 * MiB, WS_WOUT = 8 * MiB, WS_W1 = 10 * MiB, WS_W2 = 18 * MiB;
constexpr size_t WS_MISC = 26 * MiB;
constexpr size_t WS_R1 = WS_MISC;
constexpr size_t WS_GATES = WS_MISC + 65536;
constexpr size_t WS_BL = WS_GATES + 524288;
constexpr size_t WS_AC = WS_BL + 4096;
constexpr size_t WS_MPREV = WS_AC + 4096;
constexpr size_t WS_LAMB = WS_MPREV + 4096;
constexpr size_t WS_BBAR = WS_LAMB + 16384;
constexpr size_t WS_CM = WS_BBAR + 131072;
constexpr size_t WS_XEND = WS_CM + 131072;
constexpr size_t WS_XCARRY = WS_XEND + 1048576;
constexpr size_t WS_NLOC = WS_XCARRY + 1048576;
constexpr size_t WS_NPREV = WS_NLOC + 524288;
constexpr size_t WS_SS1 = WS_NPREV + 524288;
static_assert(WS_SS1 + 1048576 <= 32 * MiB, "misc region");
constexpr size_t WS_XB = 32 * MiB;
constexpr size_t WS_PROJ = 64 * MiB;
constexpr size_t WS_CLOC = 144 * MiB;
constexpr size_t WS_CPREV = 176 * MiB;
constexpr size_t WS_MIXED = 208 * MiB;
constexpr size_t WS_Z = 240 * MiB;
constexpr size_t WS_A = 64 * MiB;
constexpr size_t WS_END = 256 * MiB;
constexpr int LDS_BYTES = 147456;

#define LDS_WAIT() asm volatile("s_waitcnt lgkmcnt(0)" ::: "memory")
typedef __bf16 bf16x2n __attribute__((ext_vector_type(2)));
__device__ __forceinline__ unsigned pk2(float lo, float hi) { const f32x2v v = {lo, hi}; const bf16x2n r = __builtin_convertvector(v, bf16x2n); return __builtin_bit_cast(unsigned, r); }
__device__ __forceinline__ float bflo(unsigned w) { return __uint_as_float(w << 16); }
__device__ __forceinline__ float bfhi(unsigned w) { return __uint_as_float(w & 0xffff0000u); }
__device__ __forceinline__ float wave_sum(float v) {
#pragma unroll
    for (int o = 1; o < 64; o <<= 1) v += __shfl_xor(v, o);
    return v;
}
__device__ __forceinline__ float wave_max(float v) {
#pragma unroll
    for (int o = 1; o < 64; o <<= 1) v = fmaxf(v, __shfl_xor(v, o));
    return v;
}
__device__ __forceinline__ float wave_incl_sum(float v, int lane) {
#pragma unroll
    for (int o = 1; o < 64; o <<= 1) { const float t = __shfl_up(v, o); if (lane >= o) v += t; }
    return v;
}
__device__ __forceinline__ float wave_incl_max(float v, int lane) {
#pragma unroll
    for (int o = 1; o < 64; o <<= 1) { const float t = __shfl_up(v, o); if (lane >= o) v = fmaxf(v, t); }
    return v;
}
__device__ __forceinline__ float sigm(float x) { return 1.f / (1.f + __expf(-x)); }
__device__ __forceinline__ float logsigm(float x) { return fminf(x, 0.f) - log1pf(__expf(-fabsf(x))); }
__device__ __forceinline__ float gelu_tanh(float x) { const float a = 0.7978845608028654f * (x + 0.044715f * x * x * x); const float t = 1.f - 2.f / (1.f + __expf(2.f * a)); return 0.5f * x * (1.f + t); }
__device__ __forceinline__ void sincos_acc(float x, float& s, float& c) {
    const float j = rintf(x * 0.63661977236758134f);
    float r = fmaf(-j, 1.5703125f, x); r = fmaf(-j, 4.837512969970703125e-4f, r); r = fmaf(-j, 7.54978995489188216e-8f, r);
    const float z = r * r;
    const float sp = ((-1.9515295891e-4f * z + 8.3321608736e-3f) * z - 1.6666654611e-1f) * z * r + r;
    const float cp = ((2.443315711809948e-5f * z - 1.388731625493765e-3f) * z + 4.166664568298827e-2f) * z * z - 0.5f * z + 1.0f;
    const int q = ((int)j) & 3;
    s = (q == 0) ? sp : (q == 1) ? cp : (q == 2) ? -sp : -cp;
    c = (q == 0) ? cp : (q == 1) ? -sp : (q == 2) ? -cp : sp;
}

struct Args { const float* in[23]; float* out; unsigned char* ws; int ph_lo, ph_hi; };
struct Frame {
    LAS unsigned char* lds; unsigned char* ws; int tid, lane, wave, G, bid;
    const float* in[23]; float* out;
};
#define IN_X 0
#define IN_MIXNW 1
#define IN_WIN 2
#define IN_CONVW 3
#define IN_CONVB 4
#define IN_IBIAS 5
#define IN_FBIAS 6
#define IN_MNW 7
#define IN_LAMRE 8
#define IN_LAMIM 9
#define IN_LOGDT 10
#define IN_BRE 11
#define IN_BIM 12
#define IN_CRE 13
#define IN_CIM 14
#define IN_SSMD 15
#define IN_GLUW 16
#define IN_GLUB 17
#define IN_WOUT 18
#define IN_MLPNW 19
#define IN_WFF1 20
#define IN_WFF2 21
#define IN_FINW 22

using pg8::Unit; using pg8::HALF; using pg8::BM;
struct EpiProj {
    static constexpr bool PERM = true, AFTER_DRAIN = false;
    bf16* O; int ldc; const float* rs;
    __device__ __forceinline__ void operator()(const f32x4 (&acc)[2][2][4][2], const Unit& u, int wr, int wc, int fr, int fq) const {
        const int row0 = u.pm * BM + wr * 64 + fr, col0 = u.pn * BM + wc * 32 + 8 * fq;
#pragma unroll
        for (int ai = 0; ai < 2; ++ai)
#pragma unroll
            for (int m = 0; m < 4; ++m) { const int r = row0 + ai * HALF + m * 16; const float s = rs[r]; bf16* rowp = O + (size_t)r * ldc + col0;
#pragma unroll
                for (int bj = 0; bj < 2; ++bj) { const f32x4 v0 = acc[ai][bj][m][0] * s, v1 = acc[ai][bj][m][1] * s;
                    v4u w; w.x = pk2(v0[0], v0[1]); w.y = pk2(v0[2], v0[3]); w.z = pk2(v1[0], v1[1]); w.w = pk2(v1[2], v1[3]);
                    *(v4u*)(rowp + bj * HALF) = w; } }
    }
};
struct EpiGlu {
    static constexpr bool PERM = true, AFTER_DRAIN = false;
    bf16* O; int ldc; const bf16* Z; int ldz; const float* bias;
    __device__ __forceinline__ void operator()(const f32x4 (&acc)[2][2][4][2], const Unit& u, int wr, int wc, int fr, int fq) const {
        const int row0 = u.pm * BM + wr * 64 + fr, col0 = u.pn * BM + wc * 32 + 8 * fq;
        f32x4 bv[2][2];
#pragma unroll
        for (int bj = 0; bj < 2; ++bj)
#pragma unroll
            for (int n = 0; n < 2; ++n) bv[bj][n] = *(const f32x4*)(bias + col0 + bj * HALF + 4 * n);
#pragma unroll
        for (int ai = 0; ai < 2; ++ai)
#pragma unroll
            for (int m = 0; m < 4; ++m) { const int r = row0 + ai * HALF + m * 16;
#pragma unroll
                for (int bj = 0; bj < 2; ++bj) { const v4u zz = *(const v4u*)(Z + (size_t)r * ldz + col0 + bj * HALF);
                    const f32x4 a0 = acc[ai][bj][m][0] + bv[bj][0], a1 = acc[ai][bj][m][1] + bv[bj][1];
                    v4u w; w.x = pk2(bflo(zz.x) * sigm(a0[0]), bfhi(zz.x) * sigm(a0[1])); w.y = pk2(bflo(zz.y) * sigm(a0[2]), bfhi(zz.y) * sigm(a0[3]));
                    w.z = pk2(bflo(zz.z) * sigm(a1[0]), bfhi(zz.z) * sigm(a1[1])); w.w = pk2(bflo(zz.w) * sigm(a1[2]), bfhi(zz.w) * sigm(a1[3]));
                    *(v4u*)(O + (size_t)r * ldc + col0 + bj * HALF) = w; } }
    }
};
struct EpiOut {
    static constexpr bool PERM = true, AFTER_DRAIN = false;
    const float* X; float* OUT; bf16* XB; float* SS;
    __device__ __forceinline__ void operator()(const f32x4 (&acc)[2][2][4][2], const Unit& u, int wr, int wc, int fr, int fq) const {
        const int row0 = u.pm * BM + wr * 64 + fr, col0 = u.pn * BM + wc * 32 + 8 * fq;
#pragma unroll
        for (int ai = 0; ai < 2; ++ai)
#pragma unroll
            for (int m = 0; m < 4; ++m) { const int r = row0 + ai * HALF + m * 16; float ss = 0.f;
#pragma unroll
                for (int bj = 0; bj < 2; ++bj) { const size_t off = (size_t)r * DM + col0 + bj * HALF;
                    const f32x4 v0 = *(const f32x4*)(X + off) + acc[ai][bj][m][0], v1 = *(const f32x4*)(X + off + 4) + acc[ai][bj][m][1];
                    *(f32x4*)(OUT + off) = v0; *(f32x4*)(OUT + off + 4) = v1;
                    v4u w; w.x = pk2(v0[0], v0[1]); w.y = pk2(v0[2], v0[3]); w.z = pk2(v1[0], v1[1]); w.w = pk2(v1[2], v1[3]);
                    *(v4u*)(XB + off) = w;
                    ss += (v0[0] * v0[0] + v0[1] * v0[1]) + (v0[2] * v0[2] + v0[3] * v0[3]) + (v1[0] * v1[0] + v1[1] * v1[1]) + (v1[2] * v1[2] + v1[3] * v1[3]); }
                ss += __shfl_xor(ss, 16); ss += __shfl_xor(ss, 32);
                if (fq == 0) SS[(size_t)r * 16 + u.pn * 4 + wc] = ss; }
    }
};
struct EpiFF1 {
    static constexpr bool PERM = true, AFTER_DRAIN = false;
    bf16* O; const float* SS;
    __device__ __forceinline__ void operator()(const f32x4 (&acc)[2][2][4][2], const Unit& u, int wr, int wc, int fr, int fq) const {
        const int row0 = u.pm * BM + wr * 64 + fr, col0 = u.pn * BM + wc * 32 + 8 * fq;
#pragma unroll
        for (int ai = 0; ai < 2; ++ai)
#pragma unroll
            for (int m = 0; m < 4; ++m) { const int r = row0 + ai * HALF + m * 16;
                const f32x4* sp = (const f32x4*)(SS + (size_t)r * 16); const f32x4 s0 = sp[0], s1 = sp[1], s2 = sp[2], s3 = sp[3];
                const float tot = ((s0[0] + s0[1]) + (s0[2] + s0[3])) + ((s1[0] + s1[1]) + (s1[2] + s1[3])) + ((s2[0] + s2[1]) + (s2[2] + s2[3])) + ((s3[0] + s3[1]) + (s3[2] + s3[3]));
                const float s = 1.0f / sqrtf(tot * (1.0f / DM) + EPS);
#pragma unroll
                for (int bj = 0; bj < 2; ++bj) { f32x4 v0 = acc[ai][bj][m][0] * s, v1 = acc[ai][bj][m][1] * s;
#pragma unroll
                    for (int e = 0; e < 4; ++e) { v0[e] = fmaxf(v0[e], 0.f); v0[e] *= v0[e]; v1[e] = fmaxf(v1[e], 0.f); v1[e] *= v1[e]; }
                    v4u w; w.x = pk2(v0[0], v0[1]); w.y = pk2(v0[2], v0[3]); w.z = pk2(v1[0], v1[1]); w.w = pk2(v1[2], v1[3]);
                    *(v4u*)(O + (size_t)r * DFF + col0 + bj * HALF) = w; } }
    }
};
struct EpiFF2 {
    static constexpr bool PERM = true, AFTER_DRAIN = false;
    float* OUT;
    __device__ __forceinline__ void operator()(const f32x4 (&acc)[2][2][4][2], const Unit& u, int wr, int wc, int fr, int fq) const {
        const int row0 = u.pm * BM + wr * 64 + fr, col0 = u.pn * BM + wc * 32 + 8 * fq;
#pragma unroll
        for (int ai = 0; ai < 2; ++ai)
#pragma unroll
            for (int m = 0; m < 4; ++m) { const int r = row0 + ai * HALF + m * 16;
#pragma unroll
                for (int bj = 0; bj < 2; ++bj) { const size_t off = (size_t)r * DM + col0 + bj * HALF;
                    const f32x4 v0 = *(const f32x4*)(OUT + off) + acc[ai][bj][m][0], v1 = *(const f32x4*)(OUT + off + 4) + acc[ai][bj][m][1];
                    *(f32x4*)(OUT + off) = v0; *(f32x4*)(OUT + off + 4) = v1; } }
    }
};

__device__ __forceinline__ void p0_transpose_item(const float* __restrict__ W, int ldw, int src_n0, int K, bf16* WT, int dst_n0, const float* kscale, LAS float* scr, int k0, int lane) {
#pragma unroll 8
    for (int i = 0; i < 32; ++i) { const int kk = 2 * i + (lane >> 5); float v = W[(size_t)(k0 + kk) * ldw + src_n0 + (lane & 31)]; if (kscale) v *= kscale[k0 + kk]; scr[kk * 33 + (lane & 31)] = v; }
    LDS_WAIT();
    const int c = lane & 7;
#pragma unroll
    for (int j = 0; j < 4; ++j) { const int n = (lane >> 3) + 8 * j; const LAS float* s = scr + (8 * c) * 33 + n;
        v4u o; o.x = pk2(s[0 * 33], s[1 * 33]); o.y = pk2(s[2 * 33], s[3 * 33]); o.z = pk2(s[4 * 33], s[5 * 33]); o.w = pk2(s[6 * 33], s[7 * 33]);
        *(v4u*)(WT + (size_t)(dst_n0 + n) * K + k0 + 8 * c) = o; }
    LDS_WAIT();
}
__device__ __forceinline__ void s5_coef(const Frame& F, int g, int p, float& lbr, float& lbi, float& cr, float& ci) {
    const float dt = expf(F.in[IN_LOGDT][g]); const float lr = F.in[IN_LAMRE][g * 64 + p], li = F.in[IN_LAMIM][g * 64 + p];
    const float a = lr * dt, th = li * dt;
    float s, c, sh, ch; sincos_acc(th, s, c); sincos_acc(0.5f * th, sh, ch);
    const float e = expf(a), em1 = expm1f(a), cm1 = -2.f * sh * sh;
    lbr = e * c; lbi = e * s;
    const float nr = em1 * c + cm1, ni = lbi;
    const float inv = 1.f / (lr * lr + li * li);
    cr = (nr * lr + ni * li) * inv; ci = (ni * lr - nr * li) * inv;
}
__device__ __forceinline__ void p0_prologue(const Frame& F) {
    LAS float* scr = (LAS float*)(F.lds + F.wave * 8704);
    LAS float* WG = (LAS float*)(F.lds + 69632);
    const float* w_in = F.in[IN_WIN]; const float* mixnw = F.in[IN_MIXNW];
    for (int idx = F.tid; idx < 8192; idx += 512) { const int k = idx >> 3, j = idx & 7; WG[j * 1024 + k] = w_in[(size_t)k * INW + 2048 + j] * mixnw[k]; }
    const int gw = F.bid * 8 + F.wave, NGW = F.G * 8;
    bf16* WIN_T = (bf16*)(F.ws + WS_WIN); bf16* WGLU_T = (bf16*)(F.ws + WS_WGLU); bf16* WOUT_T = (bf16*)(F.ws + WS_WOUT); bf16* W1_T = (bf16*)(F.ws + WS_W1); bf16* W2_T = (bf16*)(F.ws + WS_W2);
    for (int it = gw; it < 6016; it += NGW) {
        int r = it;
        if (r < 1280) { const int kb = r / 80, nb = r % 80, n0 = nb * 32; p0_transpose_item(w_in, INW, n0 < 2048 ? n0 : n0 + 8, 1024, WIN_T, n0, mixnw, scr, kb * 64, F.lane); continue; } r -= 1280;
        if (r < 128) { const int kb = r / 16, nb = r % 16; p0_transpose_item(F.in[IN_GLUW], 512, nb * 32, 512, WGLU_T, nb * 32, nullptr, scr, kb * 64, F.lane); continue; } r -= 128;
        if (r < 512) { const int kb = r / 32, nb = r % 32; p0_transpose_item(F.in[IN_WOUT], 1024, nb * 32, 1024, WOUT_T, nb * 32, nullptr, scr, kb * 64, F.lane); continue; } r -= 512;
        if (r < 2048) { const int kb = r / 128, nb = r % 128; p0_transpose_item(F.in[IN_WFF1], 4096, nb * 32, 1024, W1_T, nb * 32, F.in[IN_MLPNW], scr, kb * 64, F.lane); continue; } r -= 2048;
        { const int kb = r / 32, nb = r % 32; p0_transpose_item(F.in[IN_WFF2], 1024, nb * 32, 4096, W2_T, nb * 32, nullptr, scr, kb * 64, F.lane); }
    }
    { const int gt = F.bid * 512 + F.tid, NT = F.G * 512;
      bf16* BBAR = (bf16*)(F.ws + WS_BBAR); bf16* CM = (bf16*)(F.ws + WS_CM); f32x2v* LAMB = (f32x2v*)(F.ws + WS_LAMB);
      for (int e = gt; e < 65536; e += NT) {
          { const int g = e >> 11, r = (e >> 4) & 127, c = e & 15, p = r & 63; float lbr, lbi, cr, ci; s5_coef(F, g, p, lbr, lbi, cr, ci);
            const float br = F.in[IN_BRE][(g * 64 + p) * 16 + c], bi = F.in[IN_BIM][(g * 64 + p) * 16 + c];
            const float re = cr * br - ci * bi, im = cr * bi + ci * br; BBAR[e] = (bf16)(pk2(r < 64 ? re : im, 0.f) & 0xffffu);
            if (r < 64 && c == 0) LAMB[g * 64 + p] = (f32x2v){lbr, lbi}; }
          { const int g = e >> 11, c = (e >> 7) & 15, k = e & 127, p = k & 63;
            const float v = k < 64 ? F.in[IN_CRE][(g * 16 + c) * 64 + p] : -F.in[IN_CIM][(g * 16 + c) * 64 + p]; CM[e] = (bf16)(pk2(v, 0.f) & 0xffffu); }
      } }
    __syncthreads();
    const float* x = F.in[IN_X]; bf16* XB = (bf16*)(F.ws + WS_XB); float* R1 = (float*)(F.ws + WS_R1); float* GATES = (float*)(F.ws + WS_GATES);
    for (int m = gw; m < SEQ; m += NGW) {
        const f32x4* xr = (const f32x4*)(x + (size_t)m * DM) + F.lane;
        f32x4 v[4]; float ss = 0.f;
#pragma unroll
        for (int j = 0; j < 4; ++j) { v[j] = xr[64 * j]; ss += (v[j][0] * v[j][0] + v[j][1] * v[j][1]) + (v[j][2] * v[j][2] + v[j][3] * v[j][3]); }
        ss = wave_sum(ss); const float r = 1.0f / sqrtf(ss * (1.0f / DM) + EPS);
        v2u* o8 = (v2u*)(XB + (size_t)m * DM) + F.lane;
#pragma unroll
        for (int j = 0; j < 4; ++j) { v2u w; w.x = pk2(v[j][0], v[j][1]); w.y = pk2(v[j][2], v[j][3]); o8[64 * j] = w; }
        float gv = 0.f;
#pragma unroll
        for (int g = 0; g < 8; ++g) { float a = 0.f;
#pragma unroll
            for (int j = 0; j < 4; ++j) { const f32x4 w = *(const LAS f32x4*)(WG + g * 1024 + 256 * j + 4 * F.lane); a += (v[j][0] * w[0] + v[j][1] * w[1]) + (v[j][2] * w[2] + v[j][3] * w[3]); }
            a = wave_sum(a); if (F.lane == g) gv = a * r; }
        if (F.lane < 8) GATES[(size_t)m * 8 + F.lane] = gv;
        if (F.lane == 0) R1[m] = r;
    }
}

__device__ __forceinline__ void conv8(const Frame& F, const bf16* PROJ, int t0, int tg, int col, float scale, float (&o0)[8], float (&o1)[8]) {
    const float* cw = F.in[IN_CONVW]; const float* cb = F.in[IN_CONVB];
    float w0[4], w1[4];
#pragma unroll
    for (int j = 0; j < 4; ++j) { w0[j] = cw[j * 1024 + col]; w1[j] = cw[j * 1024 + col + 1]; }
    const float b0 = cb[col], b1 = cb[col + 1];
    float x0[11], x1[11];
#pragma unroll
    for (int i = 0; i < 11; ++i) { const int tt = t0 + 8 * tg - 3 + i; unsigned w = 0u; if (tt >= 0) w = *(const unsigned*)(PROJ + (size_t)tt * NPJ + col); x0[i] = bflo(w); x1[i] = bfhi(w); }
#pragma unroll
    for (int o = 0; o < 8; ++o) {
        float a0 = b0, a1 = b1;
#pragma unroll
        for (int j = 0; j < 4; ++j) { a0 += w0[j] * x0[o + j]; a1 += w1[j] * x1[o + j]; }
        o0[o] = a0 * sigm(a0) * scale; o1[o] = a1 * sigm(a1) * scale;
    }
}
__device__ __forceinline__ void mlstm_passA(const Frame& F, int c, int h) {
    const bf16* PROJ = (const bf16*)(F.ws + WS_PROJ); const float* GATES = (const float*)(F.ws + WS_GATES);
    LAS float* WGT = (LAS float*)(F.lds); LAS bf16* KT = (LAS bf16*)(F.lds + 1024); LAS bf16* VT = (LAS bf16*)(F.lds + 19456);
    const int t0 = c * 64, unit = h * 256 + c, tid = F.tid, lane = F.lane, wave = F.wave;
    if (wave == 0) {
        const float fp = GATES[(size_t)(t0 + lane) * 8 + 4 + h] + F.in[IN_FBIAS][h], ip = GATES[(size_t)(t0 + lane) * 8 + h] + F.in[IN_IBIAS][h];
        const float b = wave_incl_sum(logsigm(fp), lane), bl = __shfl(b, 63);
        const float g = bl - b + ip, a = wave_max(g);
        WGT[lane] = __expf(g - a);
        if (lane == 0) { ((float*)(F.ws + WS_BL))[unit] = bl; ((float*)(F.ws + WS_AC))[unit] = a; }
    }
    const int cp = tid & 63, tg = tid >> 6;
    { float o0[8], o1[8]; conv8(F, PROJ, t0, tg, 512 + h * 128 + 2 * cp, 1.0f, o0, o1);
      v4u w; w.x = pk2(o0[0], o0[1]); w.y = pk2(o0[2], o0[3]); w.z = pk2(o0[4], o0[5]); w.w = pk2(o0[6], o0[7]); *(LAS v4u*)(KT + (2 * cp) * 72 + 8 * tg) = w;
      w.x = pk2(o1[0], o1[1]); w.y = pk2(o1[2], o1[3]); w.z = pk2(o1[4], o1[5]); w.w = pk2(o1[6], o1[7]); *(LAS v4u*)(KT + (2 * cp + 1) * 72 + 8 * tg) = w; }
    __syncthreads();
    { float v0[8], v1[8];
#pragma unroll
      for (int o = 0; o < 8; ++o) { const unsigned w = *(const unsigned*)(PROJ + (size_t)(t0 + 8 * tg + o) * NPJ + 1024 + h * 128 + 2 * cp); const float g = WGT[8 * tg + o]; v0[o] = bflo(w) * g; v1[o] = bfhi(w) * g; }
      v4u w; w.x = pk2(v0[0], v0[1]); w.y = pk2(v0[2], v0[3]); w.z = pk2(v0[4], v0[5]); w.w = pk2(v0[6], v0[7]); *(LAS v4u*)(VT + (2 * cp) * 72 + 8 * tg) = w;
      w.x = pk2(v1[0], v1[1]); w.y = pk2(v1[2], v1[3]); w.z = pk2(v1[4], v1[5]); w.w = pk2(v1[6], v1[7]); *(LAS v4u*)(VT + (2 * cp + 1) * 72 + 8 * tg) = w; }
    if (tid < 128) { float a = 0.f;
#pragma unroll
        for (int i = 0; i < 8; ++i) { const v4u w = *(const LAS v4u*)(KT + tid * 72 + 8 * i);
            a += bflo(w.x) * WGT[8 * i] + bfhi(w.x) * WGT[8 * i + 1] + bflo(w.y) * WGT[8 * i + 2] + bfhi(w.y) * WGT[8 * i + 3] + bflo(w.z) * WGT[8 * i + 4] + bfhi(w.z) * WGT[8 * i + 5] + bflo(w.w) * WGT[8 * i + 6] + bfhi(w.w) * WGT[8 * i + 7]; }
        ((float*)(F.ws + WS_NLOC))[(size_t)unit * 128 + tid] = a; }
    __syncthreads();
    { const int fr = lane & 15, fq = lane >> 4, nt = wave;
      bf16x8 bfr[2];
#pragma unroll
      for (int ks = 0; ks < 2; ++ks) bfr[ks] = *(const LAS bf16x8*)(VT + (16 * nt + fr) * 72 + 8 * fq + 32 * ks);
      bf16* CL = (bf16*)(F.ws + WS_CLOC) + (size_t)unit * 16384 + (size_t)(16 * nt + fr) * 128;
#pragma unroll
      for (int mp = 0; mp < 4; ++mp) { f32x4 acc[2];
#pragma unroll
          for (int e = 0; e < 2; ++e) { const int dk = 32 * mp + 8 * (fr >> 2) + 4 * e + (fr & 3); acc[e] = (f32x4){0.f, 0.f, 0.f, 0.f};
#pragma unroll
              for (int ks = 0; ks < 2; ++ks) { const bf16x8 a = *(const LAS bf16x8*)(KT + dk * 72 + 8 * fq + 32 * ks); acc[e] = __builtin_amdgcn_mfma_f32_16x16x32_bf16(a, bfr[ks], acc[e], 0, 0, 0); } }
          v4u w; w.x = pk2(acc[0][0], acc[0][1]); w.y = pk2(acc[0][2], acc[0][3]); w.z = pk2(acc[1][0], acc[1][1]); w.w = pk2(acc[1][2], acc[1][3]);
          *(v4u*)(CL + 32 * mp + 8 * fq) = w; } }
    __syncthreads();
}
__device__ __forceinline__ void mlstm_passB(const Frame& F, int c, int h) {
    const bf16* PROJ = (const bf16*)(F.ws + WS_PROJ); const float* GATES = (const float*)(F.ws + WS_GATES);
    LAS float* BT = (LAS float*)(F.lds); LAS float* ET = BT + 64; LAS float* MT = BT + 128; LAS float* ISC = BT + 192; LAS float* DINV = BT + 256;
    LAS bf16* Q = (LAS bf16*)(F.lds + 2048); LAS bf16* KK = (LAS bf16*)(F.lds + 19456); LAS bf16* VT = (LAS bf16*)(F.lds + 36864); LAS bf16* P = (LAS bf16*)(F.lds + 55296);
    LAS float* H = (LAS float*)(F.lds + 64512);
    const int t0 = c * 64, unit = h * 256 + c, tid = F.tid, lane = F.lane, wave = F.wave, fr = lane & 15, fq = lane >> 4;
    if (wave == 0) {
        const float fp = GATES[(size_t)(t0 + lane) * 8 + 4 + h] + F.in[IN_FBIAS][h], ip = GATES[(size_t)(t0 + lane) * 8 + h] + F.in[IN_IBIAS][h];
        const float b = wave_incl_sum(logsigm(fp), lane), e = ip - b, pm = wave_incl_max(e, lane);
        const float mp = ((const float*)(F.ws + WS_MPREV))[unit];
        const float mt = b + fmaxf(mp, pm);
        BT[lane] = b; ET[lane] = e; MT[lane] = mt; ISC[lane] = __expf(b + mp - mt);
    }
    const int cp = tid & 63, tg = tid >> 6;
    { float o0[8], o1[8]; conv8(F, PROJ, t0, tg, h * 128 + 2 * cp, 0.08838834764831845f, o0, o1);
#pragma unroll
      for (int o = 0; o < 8; ++o) *(LAS unsigned*)(Q + (8 * tg + o) * 136 + 2 * cp) = pk2(o0[o], o1[o]);
      conv8(F, PROJ, t0, tg, 512 + h * 128 + 2 * cp, 1.0f, o0, o1);
#pragma unroll
      for (int o = 0; o < 8; ++o) *(LAS unsigned*)(KK + (8 * tg + o) * 136 + 2 * cp) = pk2(o0[o], o1[o]); }
    { unsigned wv[8];
#pragma unroll
      for (int o = 0; o < 8; ++o) wv[o] = *(const unsigned*)(PROJ + (size_t)(t0 + 8 * tg + o) * NPJ + 1024 + h * 128 + 2 * cp);
      v4u w; w.x = (wv[0] & 0xffffu) | (wv[1] << 16); w.y = (wv[2] & 0xffffu) | (wv[3] << 16); w.z = (wv[4] & 0xffffu) | (wv[5] << 16); w.w = (wv[6] & 0xffffu) | (wv[7] << 16);
      *(LAS v4u*)(VT + (2 * cp) * 72 + 8 * tg) = w;
      w.x = (wv[0] >> 16) | (wv[1] & 0xffff0000u); w.y = (wv[2] >> 16) | (wv[3] & 0xffff0000u); w.z = (wv[4] >> 16) | (wv[5] & 0xffff0000u); w.w = (wv[6] >> 16) | (wv[7] & 0xffff0000u);
      *(LAS v4u*)(VT + (2 * cp + 1) * 72 + 8 * tg) = w; }
    __syncthreads();
    { const int mt_ = wave >> 1;
      bf16x8 aq[4];
#pragma unroll
      for (int ks = 0; ks < 4; ++ks) aq[ks] = *(const LAS bf16x8*)(Q + (16 * mt_ + fr) * 136 + 8 * fq + 32 * ks);
#pragma unroll
      for (int e = 0; e < 2; ++e) { const int nt = 2 * (wave & 1) + e; f32x4 acc = (f32x4){0.f, 0.f, 0.f, 0.f};
#pragma unroll
          for (int ks = 0; ks < 4; ++ks) { const bf16x8 bk = *(const LAS bf16x8*)(KK + (16 * nt + fr) * 136 + 8 * fq + 32 * ks); acc = __builtin_amdgcn_mfma_f32_16x16x32_bf16(aq[ks], bk, acc, 0, 0, 0); }
          const int s = 16 * nt + fr; const float es = ET[s];
#pragma unroll
          for (int j = 0; j < 4; ++j) { const int l = 16 * mt_ + 4 * fq + j; const float dm = (s <= l) ? __expf(BT[l] - MT[l] + es) : 0.f; P[l * 72 + s] = (bf16)(pk2(acc[j] * dm, 0.f) & 0xffffu); } } }
    __syncthreads();
    { const int l = tid >> 3, sub = tid & 7; const v4u pw = *(const LAS v4u*)(P + l * 72 + 8 * sub);
      float rs = (bflo(pw.x) + bfhi(pw.x)) + (bflo(pw.y) + bfhi(pw.y)) + (bflo(pw.z) + bfhi(pw.z)) + (bflo(pw.w) + bfhi(pw.w));
      const float* NP = (const float*)(F.ws + WS_NPREV) + (size_t)unit * 128 + 16 * sub; float qn = 0.f;
#pragma unroll
      for (int i = 0; i < 2; ++i) { const v4u qw = *(const LAS v4u*)(Q + l * 136 + 16 * sub + 8 * i); const f32x4 n0 = *(const f32x4*)(NP + 8 * i), n1 = *(const f32x4*)(NP + 8 * i + 4);
          qn += bflo(qw.x) * n0[0] + bfhi(qw.x) * n0[1] + bflo(qw.y) * n0[2] + bfhi(qw.y) * n0[3] + bflo(qw.z) * n1[0] + bfhi(qw.z) * n1[1] + bflo(qw.w) * n1[2] + bfhi(qw.w) * n1[3]; }
      float tot = rs + ISC[l] * qn; tot += __shfl_xor(tot, 1); tot += __shfl_xor(tot, 2); tot += __shfl_xor(tot, 4);
      if (sub == 0) DINV[l] = 1.0f / fmaxf(fabsf(tot), __expf(-MT[l])); }
    __syncthreads();
    { const int nt = wave; const bf16* CP = (const bf16*)(F.ws + WS_CPREV) + (size_t)unit * 16384 + (size_t)(16 * nt + fr) * 128 + 8 * fq;
      bf16x8 bc[4], bv[2];
#pragma unroll
      for (int ks = 0; ks < 4; ++ks) bc[ks] = *(const bf16x8*)(CP + 32 * ks);
#pragma unroll
      for (int ks = 0; ks < 2; ++ks) bv[ks] = *(const LAS bf16x8*)(VT + (16 * nt + fr) * 72 + 8 * fq + 32 * ks);
#pragma unroll
      for (int mt_ = 0; mt_ < 4; ++mt_) { f32x4 a1 = (f32x4){0.f, 0.f, 0.f, 0.f}, a2 = (f32x4){0.f, 0.f, 0.f, 0.f};
#pragma unroll
          for (int ks = 0; ks < 4; ++ks) { const bf16x8 aq = *(const LAS bf16x8*)(Q + (16 * mt_ + fr) * 136 + 8 * fq + 32 * ks); a1 = __builtin_amdgcn_mfma_f32_16x16x32_bf16(aq, bc[ks], a1, 0, 0, 0); }
#pragma unroll
          for (int ks = 0; ks < 2; ++ks) { const bf16x8 ap = *(const LAS bf16x8*)(P + (16 * mt_ + fr) * 72 + 8 * fq + 32 * ks); a2 = __builtin_amdgcn_mfma_f32_16x16x32_bf16(ap, bv[ks], a2, 0, 0, 0); }
#pragma unroll
          for (int j = 0; j < 4; ++j) { const int l = 16 * mt_ + 4 * fq + j; H[l * 132 + 16 * nt + fr] = (ISC[l] * a1[j] + a2[j]) * DINV[l]; } } }
    __syncthreads();
    { const int l = tid >> 3, seg = tid & 7; float v[16]; float s = 0.f;
#pragma unroll
      for (int i = 0; i < 4; ++i) { const f32x4 t = *(const LAS f32x4*)(H + l * 132 + 16 * seg + 4 * i); v[4 * i] = t[0]; v[4 * i + 1] = t[1]; v[4 * i + 2] = t[2]; v[4 * i + 3] = t[3]; s += (t[0] + t[1]) + (t[2] + t[3]); }
      s += __shfl_xor(s, 1); s += __shfl_xor(s, 2); s += __shfl_xor(s, 4); const float mu = s * (1.0f / 128.0f); float q = 0.f;
#pragma unroll
      for (int i = 0; i < 16; ++i) { v[i] -= mu; q += v[i] * v[i]; }
      q += __shfl_xor(q, 1); q += __shfl_xor(q, 2); q += __shfl_xor(q, 4); const float rstd = 1.0f / sqrtf(q * (1.0f / 128.0f) + EPS);
      const int col = h * 128 + 16 * seg; const float* nw = F.in[IN_MNW] + col; const bf16* op = PROJ + (size_t)(t0 + l) * NPJ + 1536 + col;
      bf16* mo = (bf16*)(F.ws + WS_MIXED) + (size_t)(t0 + l) * DM + col;
#pragma unroll
      for (int i = 0; i < 2; ++i) { const v4u ow = *(const v4u*)(op + 8 * i); const f32x4 w0 = *(const f32x4*)(nw + 8 * i), w1 = *(const f32x4*)(nw + 8 * i + 4); const float* vv = v + 8 * i;
          v4u w; w.x = pk2(vv[0] * rstd * w0[0] * sigm(bflo(ow.x)), vv[1] * rstd * w0[1] * sigm(bfhi(ow.x))); w.y = pk2(vv[2] * rstd * w0[2] * sigm(bflo(ow.y)), vv[3] * rstd * w0[3] * sigm(bfhi(ow.y)));
          w.z = pk2(vv[4] * rstd * w1[0] * sigm(bflo(ow.z)), vv[5] * rstd * w1[1] * sigm(bfhi(ow.z))); w.w = pk2(vv[6] * rstd * w1[2] * sigm(bflo(ow.w)), vv[7] * rstd * w1[3] * sigm(bfhi(ow.w)));
          *(v4u*)(mo + 8 * i) = w; } }
    __syncthreads();
}

template <bool PASS2> __device__ __forceinline__ void s5_unit(const Frame& F, int sc, int go) {
    const bf16* PROJ = (const bf16*)(F.ws + WS_PROJ);
    const int lane = F.lane, wave = F.wave, fr = lane & 15, fq = lane >> 4, g = go * 8 + wave, p = lane;
    LAS float* BU = (LAS float*)(F.lds + wave * 15360); LAS bf16* XT = (LAS bf16*)(F.lds + wave * 15360 + 10240);
    const f32x2v lam = ((const f32x2v*)(F.ws + WS_LAMB))[g * 64 + p]; const float lr = lam[0], li = lam[1];
    float xr = 0.f, xi = 0.f;
    if (PASS2) { const f32x2v x0 = ((const f32x2v*)(F.ws + WS_XCARRY))[(size_t)sc * 2048 + g * 64 + p]; xr = x0[0]; xi = x0[1]; }
    const bf16x8 zero8 = (bf16x8){0, 0, 0, 0, 0, 0, 0, 0};
    bf16x8 abb[8];
#pragma unroll
    for (int mt = 0; mt < 8; ++mt) { abb[mt] = zero8; if (fq < 2) abb[mt] = *(const bf16x8*)((const bf16*)(F.ws + WS_BBAR) + (size_t)(g * 128 + 16 * mt + fr) * 16 + 8 * fq); }
    bf16x8 acm[4]; float dd[4];
    if (PASS2) {
#pragma unroll
        for (int ks = 0; ks < 4; ++ks) acm[ks] = *(const bf16x8*)((const bf16*)(F.ws + WS_CM) + (size_t)(g * 16 + fr) * 128 + 8 * fq + 32 * ks);
#pragma unroll
        for (int j = 0; j < 4; ++j) dd[j] = F.in[IN_SSMD][g * 16 + 4 * fq + j];
    }
    for (int st = 0; st < 16; ++st) {
        const int tb = sc * 256 + st * 16;
        bf16x8 bu = zero8; if (fq < 2) bu = *(const bf16x8*)(PROJ + (size_t)(tb + fr) * NPJ + 2048 + g * 16 + 8 * fq);
#pragma unroll
        for (int mt = 0; mt < 8; ++mt) { f32x4 acc = __builtin_amdgcn_mfma_f32_16x16x32_bf16(abb[mt], bu, (f32x4){0.f, 0.f, 0.f, 0.f}, 0, 0, 0);
#pragma unroll
            for (int j = 0; j < 4; ++j) BU[(16 * mt + 4 * fq + j) * 20 + fr] = acc[j]; }
        LDS_WAIT();
        float re[16], im[16];
#pragma unroll
        for (int i = 0; i < 4; ++i) { const f32x4 a = *(const LAS f32x4*)(BU + p * 20 + 4 * i), b = *(const LAS f32x4*)(BU + (64 + p) * 20 + 4 * i);
            re[4 * i] = a[0]; re[4 * i + 1] = a[1]; re[4 * i + 2] = a[2]; re[4 * i + 3] = a[3]; im[4 * i] = b[0]; im[4 * i + 1] = b[1]; im[4 * i + 2] = b[2]; im[4 * i + 3] = b[3]; }
#pragma unroll
        for (int n = 0; n < 16; ++n) { const float nr = fmaf(lr, xr, fmaf(-li, xi, re[n])), ni = fmaf(lr, xi, fmaf(li, xr, im[n])); xr = nr; xi = ni;
            if (PASS2) { XT[n * 136 + p] = (bf16)(pk2(xr, 0.f) & 0xffffu); XT[n * 136 + 64 + p] = (bf16)(pk2(xi, 0.f) & 0xffffu); } }
        if (PASS2) {
            LDS_WAIT();
            f32x4 ay = (f32x4){0.f, 0.f, 0.f, 0.f};
#pragma unroll
            for (int ks = 0; ks < 4; ++ks) { const bf16x8 bx = *(const LAS bf16x8*)(XT + fr * 136 + 8 * fq + 32 * ks); ay = __builtin_amdgcn_mfma_f32_16x16x32_bf16(acm[ks], bx, ay, 0, 0, 0); }
            const v2u uw = *(const v2u*)(PROJ + (size_t)(tb + fr) * NPJ + 2048 + g * 16 + 4 * fq);
            const float y0 = ay[0] + dd[0] * bflo(uw.x), y1 = ay[1] + dd[1] * bfhi(uw.x), y2 = ay[2] + dd[2] * bflo(uw.y), y3 = ay[3] + dd[3] * bfhi(uw.y);
            v2u zw; zw.x = pk2(gelu_tanh(y0), gelu_tanh(y1)); zw.y = pk2(gelu_tanh(y2), gelu_tanh(y3));
            *(v2u*)((bf16*)(F.ws + WS_Z) + (size_t)(tb + fr) * 512 + g * 16 + 4 * fq) = zw;
            LDS_WAIT();
        }
    }
    if (!PASS2) ((f32x2v*)(F.ws + WS_XEND))[(size_t)sc * 2048 + g * 64 + p] = (f32x2v){xr, xi};
    __syncthreads();
}

__device__ __forceinline__ void p3_scan(const Frame& F) {
    LAS f32x2v* SOSN = (LAS f32x2v*)(F.lds); LAS f32x2v* E = (LAS f32x2v*)(F.lds + 8192); LAS float* PSEG = (LAS float*)(F.lds + 12288); LAS float* EN = (LAS float*)(F.lds + 12544);
    const int lane = F.lane, wave = F.wave, tid = F.tid;
    if (wave < 4) {
        const int h = wave;
        const f32x4 bl = *(const f32x4*)((const float*)(F.ws + WS_BL) + h * 256 + 4 * lane), a = *(const f32x4*)((const float*)(F.ws + WS_AC) + h * 256 + 4 * lane);
        const float s0 = bl[0], s1 = s0 + bl[1], s2 = s1 + bl[2], s3 = s2 + bl[3];
        const float incl = wave_incl_sum(s3, lane); float off = __shfl_up(incl, 1); if (lane == 0) off = 0.f;
        const float IB[4] = {off + s0, off + s1, off + s2, off + s3}, B[4] = {off, off + s0, off + s1, off + s2};
        const float v0 = a[0] - IB[0], v1 = a[1] - IB[1], v2 = a[2] - IB[2], v3 = a[3] - IB[3];
        const float pm0 = v0, pm1 = fmaxf(pm0, v1), pm2 = fmaxf(pm1, v2), pm3 = fmaxf(pm2, v3);
        const float inclm = wave_incl_max(pm3, lane); float exm = __shfl_up(inclm, 1); if (lane == 0) exm = -INFINITY;
        const float base = fmaxf(0.f, exm);
        const float Mex[4] = {base, fmaxf(base, pm0), fmaxf(base, pm1), fmaxf(base, pm2)}, val[4] = {v0, v1, v2, v3};
        float prod = 1.f;
#pragma unroll
        for (int k = 0; k < 4; ++k) { const float mprev = Mex[k] + B[k], mnew = fmaxf(Mex[k], val[k]) + IB[k];
            const float so = __expf(bl[k] + mprev - mnew), sn = __expf(a[k] - mnew); prod *= so;
            SOSN[h * 256 + 4 * lane + k] = (f32x2v){so, sn};
            if (F.bid == 0) ((float*)(F.ws + WS_MPREV))[h * 256 + 4 * lane + k] = mprev; }
        prod *= __shfl_xor(prod, 1); prod *= __shfl_xor(prod, 2); prod *= __shfl_xor(prod, 4); prod *= __shfl_xor(prod, 8);
        if ((lane & 15) == 0) PSEG[h * 4 + (lane >> 4)] = prod;
    }
    __syncthreads();
    for (int task = F.bid; task < 264; task += F.G) {
        if (task < 256) {
            const int h = task >> 6, seg = wave >> 1, half = wave & 1, dw = (task & 63) * 128 + half * 64 + lane;
            const unsigned* src = (const unsigned*)(F.ws + WS_CLOC) + (size_t)(h * 256 + seg * 64) * 8192 + dw;
            unsigned* dst = (unsigned*)(F.ws + WS_CPREV) + (size_t)(h * 256 + seg * 64) * 8192 + dw;
            unsigned raw[64];
#pragma unroll
            for (int i = 0; i < 64; ++i) raw[i] = src[(size_t)i * 8192];
            float a0 = 0.f, a1 = 0.f;
#pragma unroll
            for (int i = 0; i < 64; ++i) { const f32x2v ss = SOSN[h * 256 + seg * 64 + i]; a0 = ss[0] * a0 + ss[1] * bflo(raw[i]); a1 = ss[0] * a1 + ss[1] * bfhi(raw[i]); }
            E[seg * 128 + half * 64 + lane] = (f32x2v){a0, a1};
            __syncthreads();
            float x0 = 0.f, x1 = 0.f;
            for (int s = 0; s < seg; ++s) { const float ps = PSEG[h * 4 + s]; const f32x2v e = E[s * 128 + half * 64 + lane]; x0 = ps * x0 + e[0]; x1 = ps * x1 + e[1]; }
#pragma unroll
            for (int i = 0; i < 64; ++i) { dst[(size_t)i * 8192] = pk2(x0, x1); const f32x2v ss = SOSN[h * 256 + seg * 64 + i]; x0 = ss[0] * x0 + ss[1] * bflo(raw[i]); x1 = ss[0] * x1 + ss[1] * bfhi(raw[i]); }
            __syncthreads();
        } else if (task < 260) {
            const int h = task - 256, seg = tid >> 7, dk = tid & 127;
            const float* src = (const float*)(F.ws + WS_NLOC) + (size_t)(h * 256 + seg * 64) * 128 + dk; float* dst = (float*)(F.ws + WS_NPREV) + (size_t)(h * 256 + seg * 64) * 128 + dk;
            float raw[64];
#pragma unroll
            for (int i = 0; i < 64; ++i) raw[i] = src[i * 128];
            float a0 = 0.f;
#pragma unroll
            for (int i = 0; i < 64; ++i) { const f32x2v ss = SOSN[h * 256 + seg * 64 + i]; a0 = ss[0] * a0 + ss[1] * raw[i]; }
            EN[seg * 128 + dk] = a0;
            __syncthreads();
            float x0 = 0.f;
            for (int s = 0; s < seg; ++s) x0 = PSEG[h * 4 + s] * x0 + EN[s * 128 + dk];
#pragma unroll
            for (int i = 0; i < 64; ++i) { dst[i * 128] = x0; const f32x2v ss = SOSN[h * 256 + seg * 64 + i]; x0 = ss[0] * x0 + ss[1] * raw[i]; }
            __syncthreads();
        } else {
            const int ch = (task - 260) * 512 + tid;
            f32x2v lam = ((const f32x2v*)(F.ws + WS_LAMB))[ch];
#pragma unroll
            for (int i = 0; i < 8; ++i) lam = (f32x2v){lam[0] * lam[0] - lam[1] * lam[1], 2.f * lam[0] * lam[1]};
            const f32x2v* src = (const f32x2v*)(F.ws + WS_XEND) + ch; f32x2v* dst = (f32x2v*)(F.ws + WS_XCARRY) + ch;
            float xr = 0.f, xi = 0.f;
#pragma unroll 16
            for (int sc = 0; sc < 64; ++sc) { dst[(size_t)sc * 2048] = (f32x2v){xr, xi}; const f32x2v e = src[(size_t)sc * 2048];
                const float nr = lam[0] * xr - lam[1] * xi + e[0], ni = lam[0] * xi + lam[1] * xr + e[1]; xr = nr; xi = ni; }
        }
    }
}

__device__ __forceinline__ void p9_final(const Frame& F) {
    const int gw = F.bid * 8 + F.wave, NGW = F.G * 8; const float* fw = F.in[IN_FINW];
    f32x4 wv[4];
#pragma unroll
    for (int j = 0; j < 4; ++j) wv[j] = *((const f32x4*)fw + F.lane + 64 * j);
    for (int m = gw; m < SEQ; m += NGW) {
        f32x4* xr = (f32x4*)(F.out + (size_t)m * DM) + F.lane;
        f32x4 v[4]; float ss = 0.f;
#pragma unroll
        for (int j = 0; j < 4; ++j) { v[j] = xr[64 * j]; ss += (v[j][0] * v[j][0] + v[j][1] * v[j][1]) + (v[j][2] * v[j][2] + v[j][3] * v[j][3]); }
        ss = wave_sum(ss); const float r = 1.0f / sqrtf(ss * (1.0f / DM) + EPS);
#pragma unroll
        for (int j = 0; j < 4; ++j) xr[64 * j] = v[j] * r * wv[j];
    }
}

__global__ void __launch_bounds__(512, 2) hymba_fwd(Args args) {
    extern __shared__ __attribute__((aligned(16))) unsigned char lds_raw[];
    cg::grid_group grid = cg::this_grid();
    Frame F;
    F.lds = (LAS unsigned char*)lds_raw; F.ws = args.ws; F.tid = threadIdx.x; F.lane = F.tid & 63; F.wave = __builtin_amdgcn_readfirstlane(F.tid >> 6); F.G = gridDim.x; F.bid = blockIdx.x;
#pragma unroll
    for (int i = 0; i < 23; ++i) F.in[i] = args.in[i];
    F.out = args.out;
    const int lo = args.ph_lo, hi = args.ph_hi;
#define IN(k) (lo <= (k) && (k) < hi)
#define SEAM(k) do { if (IN(k) && IN((k) + 1)) grid.sync(); } while (0)
    bf16* XB = (bf16*)(F.ws + WS_XB); bf16* PROJ = (bf16*)(F.ws + WS_PROJ); bf16* MIXED = (bf16*)(F.ws + WS_MIXED); bf16* Z = (bf16*)(F.ws + WS_Z); bf16* AB = (bf16*)(F.ws + WS_A);
    float* SS1 = (float*)(F.ws + WS_SS1);
    if (IN(0)) { p0_prologue(F); }
    SEAM(0);
    if (IN(1)) { pg8::Gemm g{XB, (const bf16*)(F.ws + WS_WIN), SEQ, NPJ, DM}; pg8::StaticOrder S; S.init(SEQ, NPJ, F.G, F.bid);
        EpiProj E{PROJ, NPJ, (const float*)(F.ws + WS_R1)};
        pg8::gemm_phase<EpiProj, pg8::StaticOrder, true, true>(F.lds, g, S, E); }
    SEAM(1);
    if (IN(2)) { for (int u = F.bid; u < 1024; u += F.G) mlstm_passA(F, u >> 2, u & 3);
        for (int u = F.bid; u < 256; u += F.G) s5_unit<false>(F, u >> 2, u & 3); }
    SEAM(2);
    if (IN(3)) { p3_scan(F); }
    SEAM(3);
    if (IN(4)) { for (int u = F.bid; u < 1024; u += F.G) mlstm_passB(F, u >> 2, u & 3);
        for (int u = F.bid; u < 256; u += F.G) s5_unit<true>(F, u >> 2, u & 3); }
    SEAM(4);
    if (IN(5)) { pg8::Gemm g{Z, (const bf16*)(F.ws + WS_WGLU), SEQ, 512, 512}; pg8::StaticOrder S; S.init(SEQ, 512, F.G, F.bid);
        EpiGlu E{MIXED + 512, DM, Z, 512, F.in[IN_GLUB]};
        pg8::gemm_phase<EpiGlu, pg8::StaticOrder, true, true>(F.lds, g, S, E); }
    SEAM(5);
    if (IN(6)) { pg8::Gemm g{MIXED, (const bf16*)(F.ws + WS_WOUT), SEQ, DM, DM}; pg8::StaticOrder S; S.init(SEQ, DM, F.G, F.bid);
        EpiOut E{F.in[IN_X], F.out, XB, SS1};
        pg8::gemm_phase<EpiOut, pg8::StaticOrder, true, true>(F.lds, g, S, E); }
    SEAM(6);
    if (IN(7)) { pg8::Gemm g{XB, (const bf16*)(F.ws + WS_W1), SEQ, DFF, DM}; pg8::StaticOrder S; S.init(SEQ, DFF, F.G, F.bid);
        EpiFF1 E{AB, SS1};
        pg8::gemm_phase<EpiFF1, pg8::StaticOrder, true, true>(F.lds, g, S, E); }
    SEAM(7);
    if (IN(8)) { pg8::Gemm g{AB, (const bf16*)(F.ws + WS_W2), SEQ, DM, DFF}; pg8::StaticOrder S; S.init(SEQ, DM, F.G, F.bid);
        EpiFF2 E{F.out};
        pg8::gemm_phase<EpiFF2, pg8::StaticOrder, true, true>(F.lds, g, S, E); }
    SEAM(8);
    if (IN(9)) { p9_final(F); }
#undef IN
#undef SEAM
}

extern "C" void kernel_launch(void* const* d_in, const int* in_sizes, int n_in, void* d_out, int out_size, void* d_ws, size_t ws_size, hipStream_t stream) {
    static int grid = 0;
    if (grid == 0) {
        if (n_in != 23 || out_size != SEQ * DM || ws_size < WS_END) { fprintf(stderr, "kernel_launch: unexpected shapes (n_in %d out %d ws %zu)\n", n_in, out_size, ws_size); grid = -1; return; }
        int dev = 0, cus = 0, per_cu = 0;
        hipGetDevice(&dev); hipDeviceGetAttribute(&cus, hipDeviceAttributeMultiprocessorCount, dev);
        if (hipFuncSetAttribute((const void*)hymba_fwd, hipFuncAttributeMaxDynamicSharedMemorySize, LDS_BYTES) != hipSuccess) { fprintf(stderr, "kernel_launch: hipFuncSetAttribute failed\n"); grid = -1; return; }
        if (hipOccupancyMaxActiveBlocksPerMultiprocessor(&per_cu, (const void*)hymba_fwd, 512, LDS_BYTES) != hipSuccess || per_cu < 1) { fprintf(stderr, "kernel_launch: occupancy query says %d\n", per_cu); per_cu = 1; }
        (void)hipGetLastError();
        grid = cus * 1;
        if (grid > 256) grid = 256;
    }
    if (grid < 0) return;
    Args a{};
    for (int i = 0; i < 23; ++i) a.in[i] = (const float*)d_in[i];
    a.out = (float*)d_out; a.ws = (unsigned char*)d_ws;
#if MK_N_LAUNCHES == 1
    a.ph_lo = 0; a.ph_hi = NPHASE;
    void* kargs[] = {&a};
    hipError_t e = hipLaunchCooperativeKernel((const void*)hymba_fwd, dim3(grid), dim3(512), kargs, LDS_BYTES, stream);
    if (e != hipSuccess) fprintf(stderr, "cooperative launch failed: %s (grid %d)\n", hipGetErrorString(e), grid);
#else
    for (int k = 0; k < NPHASE; ++k) { a.ph_lo = k; a.ph_hi = k + 1; hipLaunchKernelGGL(hymba_fwd, dim3(grid), dim3(512), LDS_BYTES, stream, a); }
#endif
}
```

```cpp
#include <hip/hip_runtime.h>
#include <hip/hip_cooperative_groups.h>
#include <cstdio>
#include <cstdint>
namespace cg = cooperative_groups;
namespace pg8 {
#define PG8_LAS __attribute__((address_space(3)))
typedef unsigned short bf16_t;
typedef short bf16x8 __attribute__((ext_vector_type(8)));
typedef float f32x4 __attribute__((ext_vector_type(4)));
typedef unsigned u32x4 __attribute__((ext_vector_type(4)));
constexpr int BM = 256, BK = 64, HALF = 128, HTB = HALF * BK * 2  , STAGE_BYTES = 8 * HTB, NXCD = 8, WGM = 8;

__host__ __device__ __forceinline__ int lds_byte(int r, int c) { const int st = (r >> 4) * 2 + (c >> 5), rr = r & 15, cc = c & 31, ob = rr * 64 + cc * 2; return st * 1024 + (ob ^ (((ob >> 9) & 1) << 5)); }
__host__ __device__ __forceinline__ void stage_rc(int b, int& R, int& C) { const int st = b / 1024, sb = b % 1024, swz = sb ^ (((sb >> 9) & 1) << 5); R = (st >> 1) * 16 + swz / 64; C = (st & 1) * 32 + (swz % 64) / 2; }
__host__ __device__ __forceinline__ int perm32(int rho) { const int n = rho >> 4, i = rho & 15; return 8 * (i >> 2) + 4 * n + (i & 3); }

struct Unit { int pm, pn; };
struct Gemm { const bf16_t* A; const bf16_t* Bt; int M, N, K; };

struct StaticOrder {
    int nM, nN, nwg, G, c;
    __host__ __device__ void init(int M, int N, int G_, int c_) { nM = M / BM; nN = N / BM; nwg = nM * nN; G = G_; c = c_; }
    __host__ __device__ bool next(int i, Unit& u) const {
        const long L = (long)i * G + c; if (L >= nwg) return false;
        int wgid = (int)L; { const int q = nwg / NXCD, r = nwg % NXCD, xcd = wgid % NXCD, off = wgid / NXCD; wgid = (xcd < r ? xcd * (q + 1) : r * (q + 1) + (xcd - r) * q) + off; }
        const int nig = WGM * nN, gid = wgid / nig, fm = gid * WGM, gsz = (nM - fm) < WGM ? (nM - fm) : WGM;
        u.pm = fm + ((wgid % nig) % gsz); u.pn = (wgid % nig) / gsz; return true;
    }
    __device__ __forceinline__ void a_ready(const Unit&) const {}
    __device__ __forceinline__ void done(const Unit&) const {}
};

__device__ __forceinline__ unsigned cvt_pk_bf16(float lo, float hi) { unsigned r; asm volatile("v_cvt_pk_bf16_f32 %0, %1, %2" : "=v"(r) : "v"(lo), "v"(hi)); return r; }
typedef float f32x2 __attribute__((ext_vector_type(2)));

template <class Epi, class Sched, bool ALIGN_EPI = false, bool SP2 = false>
__device__ __forceinline__ void gemm_phase(PG8_LAS unsigned char* lds, const Gemm g, const Sched& S, const Epi& E) {
    const int tid = threadIdx.x, wid = __builtin_amdgcn_readfirstlane(tid >> 6), lane = tid & 63, wr = wid >> 2, wc = wid & 3, fr = lane & 15, fq = lane >> 4;
    const int K = g.K, nt = K / BK;
    unsigned voffA[2], voffB[2];
#pragma unroll
    for (int i = 0; i < 2; ++i) { int R, C; stage_rc(tid * 16 + i * 8192, R, C); const int Rb = Epi::PERM ? ((R & ~31) + perm32(R & 31)) : R;
        voffA[i] = (unsigned)(R * K + C) * 2u; voffB[i] = (unsigned)(Rb * K + C) * 2u; }
    const size_t kstep = (size_t)(BK * 2);
    const size_t hstep = (size_t)HALF * K * 2;
    const size_t tstep = 2 * hstep;
    const unsigned ldsw = (unsigned)wid * 1024u;
    const int aoff = lds_byte(wr * 64 + fr, fq * 8), boff = lds_byte(wc * 32 + fr, fq * 8);
#define PG8_SA(b, h) (((b) * 2 + (h)) * HTB)
#define PG8_SB(b, h) ((4 + (b) * 2 + (h)) * HTB)
#define PG8_STAGE(bufoff, gbase, voff) do { _Pragma("unroll") for (int _i = 0; _i < 2; ++_i) \
        __builtin_amdgcn_global_load_lds((const unsigned*)((const char*)(gbase) + (voff)[_i]), (PG8_LAS unsigned*)(lds + (bufoff) + ldsw + _i * 8192), 16, 0, 0); } while (0)
#define PG8_LDA(dst, b, h) do { _Pragma("unroll") for (int m = 0; m < 4; ++m) _Pragma("unroll") for (int k = 0; k < 2; ++k) dst[m][k] = *(const PG8_LAS bf16x8*)(lds + PG8_SA(b, h) + aoff + m * 2048 + k * 1024); } while (0)
#define PG8_LDB(dst, b, h) do { _Pragma("unroll") for (int n = 0; n < 2; ++n) _Pragma("unroll") for (int k = 0; k < 2; ++k) dst[n][k] = *(const PG8_LAS bf16x8*)(lds + PG8_SB(b, h) + boff + n * 2048 + k * 1024); } while (0)
#define PG8_MMA(ai, bj, At, Bt) do { __builtin_amdgcn_s_setprio(1); _Pragma("unroll") for (int m = 0; m < 4; ++m) _Pragma("unroll") for (int n = 0; n < 2; ++n) _Pragma("unroll") for (int k = 0; k < 2; ++k) \
        acc[ai][bj][m][n] = __builtin_amdgcn_mfma_f32_16x16x32_bf16(Bt[n][k], At[m][k], acc[ai][bj][m][n], 0, 0, 0); __builtin_amdgcn_s_setprio(0); } while (0)
#define PG8_WAIT_V(n) asm volatile("s_waitcnt vmcnt(" #n ")" ::: "memory")
#define PG8_WAIT_L(n) asm volatile("s_waitcnt lgkmcnt(" #n ")" ::: "memory")
#define PG8_BAR __builtin_amdgcn_s_barrier()
#define PG8_SCHED __builtin_amdgcn_sched_barrier(0)
    Unit cur, nxt; int ui = 0;
    if (!S.next(0, cur)) return;
    f32x4 acc[2][2][4][2];
#pragma unroll
    for (int a = 0; a < 2; ++a)
#pragma unroll
        for (int b = 0; b < 2; ++b)
#pragma unroll
            for (int m = 0; m < 4; ++m)
#pragma unroll
                for (int n = 0; n < 2; ++n) acc[a][b][m][n] = (f32x4){0.f, 0.f, 0.f, 0.f};
    bf16x8 At[4][2], B0[2][2], B1[2][2];
    const char* cA = (const char*)g.A + (size_t)cur.pm * tstep; const char* cB = (const char*)g.Bt + (size_t)cur.pn * tstep;
    S.a_ready(cur);
    if constexpr (SP2) {
        PG8_STAGE(PG8_SB(0, 0), cB, voffB); PG8_STAGE(PG8_SB(0, 1), cB + hstep, voffB); PG8_STAGE(PG8_SA(0, 0), cA, voffA); PG8_STAGE(PG8_SA(0, 1), cA + hstep, voffA);
        if (wr == 1) PG8_BAR;
        PG8_WAIT_V(2); PG8_BAR;
        PG8_STAGE(PG8_SB(1, 0), cB + kstep, voffB); PG8_STAGE(PG8_SA(1, 0), cA + kstep, voffA); PG8_STAGE(PG8_SB(1, 1), cB + hstep + kstep, voffB);
        PG8_WAIT_V(6); PG8_BAR;
    } else {
        PG8_STAGE(PG8_SB(0, 0), cB, voffB); PG8_STAGE(PG8_SA(0, 0), cA, voffA); PG8_STAGE(PG8_SB(0, 1), cB + hstep, voffB); PG8_STAGE(PG8_SA(0, 1), cA + hstep, voffA);
        if (wr == 1) PG8_BAR;
        PG8_WAIT_V(4); PG8_BAR;
        PG8_STAGE(PG8_SB(1, 0), cB + kstep, voffB); PG8_STAGE(PG8_SA(1, 0), cA + kstep, voffA); PG8_STAGE(PG8_SB(1, 1), cB + hstep + kstep, voffB);
        PG8_WAIT_V(6); PG8_BAR;
    }
    for (;;) {
        const bool has_next = S.next(ui + 1, nxt);
        const char* nA = has_next ? (const char*)g.A + (size_t)nxt.pm * tstep : cA; const char* nB = has_next ? (const char*)g.Bt + (size_t)nxt.pn * tstep : cB;
        for (int t = 0; t < nt; t += 2) {
            const bool last = (t == nt - 2);
            const char* a1 = cA + (size_t)(t + 1) * kstep;
            const char* a2 = last ? nA : cA + (size_t)(t + 2) * kstep; const char* b2 = last ? nB : cB + (size_t)(t + 2) * kstep;
            const char* a3 = a2 + kstep; const char* b3 = b2 + kstep;
            if (last && has_next) S.a_ready(nxt);
            if constexpr (SP2) {
            PG8_LDB(B0, 0, 0); PG8_LDB(B1, 0, 1); PG8_SCHED; PG8_LDA(At, 0, 0); PG8_STAGE(PG8_SA(1, 1), a1 + hstep, voffA);
            PG8_WAIT_V(8); PG8_WAIT_L(0); PG8_BAR; PG8_MMA(0, 0, At, B0); PG8_MMA(0, 1, At, B1); PG8_BAR; PG8_SCHED;
            PG8_LDA(At, 0, 1); PG8_STAGE(PG8_SB(0, 0), b2, voffB); PG8_STAGE(PG8_SB(0, 1), b2 + hstep, voffB); PG8_STAGE(PG8_SA(0, 0), a2, voffA);
            PG8_WAIT_V(8); PG8_WAIT_L(0); PG8_BAR; PG8_MMA(1, 0, At, B0); PG8_MMA(1, 1, At, B1); PG8_BAR; PG8_SCHED;
            PG8_LDB(B0, 1, 0); PG8_LDB(B1, 1, 1); PG8_SCHED; PG8_LDA(At, 1, 0); PG8_STAGE(PG8_SA(0, 1), a2 + hstep, voffA);
            PG8_WAIT_V(8); PG8_WAIT_L(0); PG8_BAR; PG8_MMA(0, 0, At, B0); PG8_MMA(0, 1, At, B1); PG8_BAR; PG8_SCHED;
            PG8_LDA(At, 1, 1); PG8_STAGE(PG8_SB(1, 0), b3, voffB); PG8_STAGE(PG8_SB(1, 1), b3 + hstep, voffB); PG8_STAGE(PG8_SA(1, 0), a3, voffA);
            PG8_WAIT_V(8); PG8_WAIT_L(0); PG8_BAR; PG8_MMA(1, 0, At, B0); PG8_MMA(1, 1, At, B1); PG8_BAR; PG8_SCHED;
            } else {
            PG8_LDB(B0, 0, 0); PG8_SCHED; PG8_LDA(At, 0, 0); PG8_STAGE(PG8_SA(1, 1), a1 + hstep, voffA);
            PG8_WAIT_L(8); PG8_BAR; PG8_WAIT_L(0); PG8_MMA(0, 0, At, B0); PG8_BAR; PG8_SCHED;
            PG8_LDB(B1, 0, 1); PG8_STAGE(PG8_SB(0, 0), b2, voffB);
            PG8_BAR; PG8_WAIT_L(0); PG8_MMA(0, 1, At, B1); PG8_BAR;
            PG8_LDA(At, 0, 1); PG8_STAGE(PG8_SA(0, 0), a2, voffA);
            PG8_BAR; PG8_WAIT_L(0); PG8_MMA(1, 0, At, B0); PG8_BAR; PG8_SCHED;
            PG8_STAGE(PG8_SB(0, 1), b2 + hstep, voffB);
            PG8_WAIT_V(6); PG8_BAR; PG8_MMA(1, 1, At, B1); PG8_BAR;
            PG8_LDB(B0, 1, 0); PG8_SCHED; PG8_LDA(At, 1, 0); PG8_STAGE(PG8_SA(0, 1), a2 + hstep, voffA);
            PG8_WAIT_L(8); PG8_BAR; PG8_WAIT_L(0); PG8_MMA(0, 0, At, B0); PG8_BAR; PG8_SCHED;
            PG8_LDB(B1, 1, 1); PG8_STAGE(PG8_SB(1, 0), b3, voffB);
            PG8_BAR; PG8_WAIT_L(0); PG8_MMA(0, 1, At, B1); PG8_BAR;
            PG8_LDA(At, 1, 1); PG8_STAGE(PG8_SA(1, 0), a3, voffA);
            PG8_BAR; PG8_WAIT_L(0); PG8_MMA(1, 0, At, B0); PG8_BAR; PG8_SCHED;
            PG8_STAGE(PG8_SB(1, 1), b3 + hstep, voffB);
            PG8_WAIT_V(6); PG8_BAR; PG8_MMA(1, 1, At, B1); PG8_BAR;
            }
        }
        if constexpr (ALIGN_EPI) { if (wr == 0) PG8_BAR; }
        if constexpr (!Epi::AFTER_DRAIN) { E(acc, cur, wr, wc, fr, fq); S.done(cur); }
        if (!has_next) break;
#pragma unroll
        for (int a = 0; a < 2; ++a)
#pragma unroll
            for (int b = 0; b < 2; ++b)
#pragma unroll
                for (int m = 0; m < 4; ++m)
#pragma unroll
                    for (int n = 0; n < 2; ++n) acc[a][b][m][n] = (f32x4){0.f, 0.f, 0.f, 0.f};
        cur = nxt; cA = nA; cB = nB; ++ui;
        if constexpr (ALIGN_EPI) { if (wr == 1) PG8_BAR; }
    }
    PG8_WAIT_V(0);
    if constexpr (!ALIGN_EPI) { if (wr == 0) PG8_BAR; }
    PG8_BAR;
    if constexpr (Epi::AFTER_DRAIN) { E.fused(acc, cur, wr, wc, fr, fq, lds, wid, lane); S.done(cur); }
#undef PG8_SA
#undef PG8_SB
#undef PG8_STAGE
#undef PG8_LDA
#undef PG8_LDB
#undef PG8_MMA
#undef PG8_WAIT_V
#undef PG8_WAIT_L
#undef PG8_BAR
#undef PG8_SCHED
}
}

#ifndef MK_N_LAUNCHES
#define MK_N_LAUNCHES 1
#endif
#define LAS __attribute__((address_space(3)))
typedef unsigned short bf16;
typedef unsigned v4u __attribute__((ext_vector_type(4)));
typedef unsigned v2u __attribute__((ext_vector_type(2)));
typedef float f32x4 __attribute__((ext_vector_type(4)));
typedef float f32x2v __attribute__((ext_vector_type(2)));
typedef short bf16x8 __attribute__((ext_vector_type(8)));

constexpr int SEQ = 16384, DM = 1024, NPJ = 2560, DFF = 4096, NCHUNK = 256, NPHASE = 10;
constexpr int INW = 2568;
constexpr float EPS = 1e-6f;
constexpr size_t MiB = 1u << 20;
constexpr size_t WS_CTL = 0, CTL_ZERO_BYTES = 16384;
constexpr size_t WS_WIN = 2 * MiB, WS_WGLU = 7 * MiB, WS_WOUT = 8 * MiB, WS_W1 = 10 * MiB, WS_W2 = 18 * MiB;
constexpr size_t WS_MISC = 26 * MiB;
constexpr size_t WS_R1 = WS_MISC;
constexpr size_t WS_GATES = WS_MISC + 65536;
constexpr size_t WS_BL = WS_GATES + 524288;
constexpr size_t WS_AC = WS_BL + 4096;
constexpr size_t WS_MPREV = WS_AC + 4096;
constexpr size_t WS_LAMB = WS_MPREV + 4096;
constexpr size_t WS_BBAR = WS_LAMB + 16384;
constexpr size_t WS_CM = WS_BBAR + 131072;
constexpr size_t WS_XEND = WS_CM + 131072;
constexpr size_t WS_XCARRY = WS_XEND + 1048576;
constexpr size_t WS_NLOC = WS_XCARRY + 1048576;
constexpr size_t WS_NPREV = WS_NLOC + 524288;
constexpr size_t WS_SS1 = WS_NPREV + 524288;
static_assert(WS_SS1 + 1048576 <= 32 * MiB, "misc region");
constexpr size_t WS_XB = 32 * MiB;
constexpr size_t WS_PROJ = 64 * MiB;
constexpr size_t WS_CLOC = 144 * MiB;
constexpr size_t WS_CPREV = 176 * MiB;
constexpr size_t WS_MIXED = 208 * MiB;
constexpr size_t WS_Z = 240 * MiB;
constexpr size_t WS_A = 64 * MiB;
constexpr size_t WS_END = 256 * MiB;
constexpr int LDS_BYTES = 147456;

#define LDS_WAIT() asm volatile("s_waitcnt lgkmcnt(0)" ::: "memory")
typedef __bf16 bf16x2n __attribute__((ext_vector_type(2)));
__device__ __forceinline__ unsigned pk2(float lo, float hi) { const f32x2v v = {lo, hi}; const bf16x2n r = __builtin_convertvector(v, bf16x2n); return __builtin_bit_cast(unsigned, r); }
__device__ __forceinline__ float bflo(unsigned w) { return __uint_as_float(w << 16); }
__device__ __forceinline__ float bfhi(unsigned w) { return __uint_as_float(w & 0xffff0000u); }
__device__ __forceinline__ float wave_sum(float v) {
#pragma unroll
    for (int o = 1; o < 64; o <<= 1) v += __shfl_xor(v, o);
    return v;
}
__device__ __forceinline__ float wave_max(float v) {
#pragma unroll
    for (int o = 1; o < 64; o <<= 1) v = fmaxf(v, __shfl_xor(v, o));
    return v;
}
__device__ __forceinline__ float wave_incl_sum(float v, int lane) {
#pragma unroll
    for (int o = 1; o < 64; o <<= 1) { const float t = __shfl_up(v, o); if (lane >= o) v += t; }
    return v;
}
__device__ __forceinline__ float wave_incl_max(float v, int lane) {
#pragma unroll
    for (int o = 1; o < 64; o <<= 1) { const float t = __shfl_up(v, o); if (lane >= o) v = fmaxf(v, t); }
    return v;
}
__device__ __forceinline__ float sigm(float x) { return 1.f / (1.f + __expf(-x)); }
__device__ __forceinline__ float logsigm(float x) { return fminf(x, 0.f) - log1pf(__expf(-fabsf(x))); }
__device__ __forceinline__ float gelu_tanh(float x) { const float a = 0.7978845608028654f * (x + 0.044715f * x * x * x); const float t = 1.f - 2.f / (1.f + __expf(2.f * a)); return 0.5f * x * (1.f + t); }
__device__ __forceinline__ void sincos_acc(float x, float& s, float& c) {
    const float j = rintf(x * 0.63661977236758134f);
    float r = fmaf(-j, 1.5703125f, x); r = fmaf(-j, 4.837512969970703125e-4f, r); r = fmaf(-j, 7.54978995489188216e-8f, r);
    const float z = r * r;
    const float sp = ((-1.9515295891e-4f * z + 8.3321608736e-3f) * z - 1.6666654611e-1f) * z * r + r;
    const float cp = ((2.443315711809948e-5f * z - 1.388731625493765e-3f) * z + 4.166664568298827e-2f) * z * z - 0.5f * z + 1.0f;
    const int q = ((int)j) & 3;
    s = (q == 0) ? sp : (q == 1) ? cp : (q == 2) ? -sp : -cp;
    c = (q == 0) ? cp : (q == 1) ? -sp : (q == 2) ? -cp : sp;
}

#define XB_TMO      128
#define XB_XCNT(j)  (256  + 64 * (j))
#define XB_XSUB(j)  (1280 + 64 * (j))
#define XB_XGEN(j)  (2304 + 64 * (j))
#define XB_TOP      3328
#define XB_TOPGEN   3392
#define XCD_BAR_WORDS 3456
#define XB_SPIN_CAP (1u << 18)

__device__ __forceinline__ unsigned xb_ld(unsigned* p)              { return __hip_atomic_load(p, __ATOMIC_RELAXED, __HIP_MEMORY_SCOPE_AGENT); }
__device__ __forceinline__ unsigned xb_add(unsigned* p, unsigned v) { return __hip_atomic_fetch_add(p, v, __ATOMIC_RELAXED, __HIP_MEMORY_SCOPE_AGENT); }
__device__ __forceinline__ unsigned xb_xcc_id() { return (unsigned)__builtin_amdgcn_s_getreg((3 << 11) | 20) & 0xFu; }
#define XB_SPIN(cond, bar) do { unsigned _sp = 0; while (cond) { __builtin_amdgcn_s_sleep(1); \
    if ((++_sp & 255u) == 0u) { if (xb_ld(&(bar)[XB_TMO])) break; if (_sp > XB_SPIN_CAP) { atomicAdd(&(bar)[XB_TMO], 1u); break; } } } } while (0)

struct XcdBarrier {
    unsigned* bar; unsigned x;
    volatile LAS unsigned* st;
};

__device__ __forceinline__ XcdBarrier xcd_barrier_post(unsigned* bar, volatile LAS unsigned* st) {
    XcdBarrier b; b.bar = bar; b.x = xb_xcc_id(); b.st = st;
    if (threadIdx.x == 0) (void)xb_add(&bar[XB_XCNT(b.x)], 1u);
    return b;
}
__device__ __forceinline__ void xcd_barrier_complete(unsigned* bar, unsigned x, unsigned& nloc, unsigned& nx) {
    const unsigned G = gridDim.x * gridDim.y * gridDim.z;
    unsigned sum, cnt, mine, sp = 0u;
    for (;;) {
        sum = 0u; cnt = 0u; mine = 0u;
#pragma unroll
        for (unsigned j = 0; j < 16; ++j) { const unsigned c = xb_ld(&bar[XB_XCNT(j)]); sum += c; cnt += (c > 0u) ? 1u : 0u; mine = (j == x) ? c : mine; }
        if (sum == G) break;
        __builtin_amdgcn_s_sleep(1);
        if ((++sp & 255u) == 0u) { if (xb_ld(&bar[XB_TMO])) break; if (sp > XB_SPIN_CAP) { atomicAdd(&bar[XB_TMO], 1u); break; } }
    }
    nloc = mine > 0u ? mine : 1u; nx = cnt > 0u ? cnt : 1u;
}

__device__ __forceinline__ void xcd_barrier(const XcdBarrier& b) {
    asm volatile("s_waitcnt vmcnt(0)" ::: "memory");
    __syncthreads();
    if (threadIdx.x == 0) {
        unsigned* bar = b.bar;
        __builtin_amdgcn_s_waitcnt(0);
        unsigned nloc = b.st[0], nx = b.st[1];
        if (nloc == 0u) { xcd_barrier_complete(bar, b.x, nloc, nx); b.st[0] = nloc; b.st[1] = nx; }
        const unsigned old = xb_add(&bar[XB_XSUB(b.x)], 1u);
        const unsigned gen = old / nloc;
        if (old + 1u == (gen + 1u) * nloc) {
            __builtin_amdgcn_fence(__ATOMIC_RELEASE, "agent");
            asm volatile("s_waitcnt vmcnt(0)" ::: "memory");
            const unsigned og = xb_add(&bar[XB_TOP], 1u);
            const unsigned tg = og / nx;
            if (og + 1u == (tg + 1u) * nx) xb_add(&bar[XB_TOPGEN], 1u);
            else XB_SPIN(xb_ld(&bar[XB_TOPGEN]) == tg, bar);
            __builtin_amdgcn_fence(__ATOMIC_ACQUIRE, "agent");
            xb_add(&bar[XB_XGEN(b.x)], 1u);
            asm volatile("s_waitcnt vmcnt(0)" ::: "memory");
        } else {
            XB_SPIN(xb_ld(&bar[XB_XGEN(b.x)]) == gen, bar);
            __builtin_amdgcn_fence(__ATOMIC_ACQUIRE, "agent");
            asm volatile("s_waitcnt vmcnt(0)" ::: "memory");
        }
    }
    __syncthreads();
}

struct Args { const float* in[23]; float* out; unsigned char* ws; int ph_lo, ph_hi; };
struct Frame {
    LAS unsigned char* lds; unsigned char* ws; int tid, lane, wave, G, bid;
    const float* in[23]; float* out;
};
#define IN_X 0
#define IN_MIXNW 1
#define IN_WIN 2
#define IN_CONVW 3
#define IN_CONVB 4
#define IN_IBIAS 5
#define IN_FBIAS 6
#define IN_MNW 7
#define IN_LAMRE 8
#define IN_LAMIM 9
#define IN_LOGDT 10
#define IN_BRE 11
#define IN_BIM 12
#define IN_CRE 13
#define IN_CIM 14
#define IN_SSMD 15
#define IN_GLUW 16
#define IN_GLUB 17
#define IN_WOUT 18
#define IN_MLPNW 19
#define IN_WFF1 20
#define IN_WFF2 21
#define IN_FINW 22

using pg8::Unit; using pg8::HALF; using pg8::BM;
struct EpiProj {
    static constexpr bool PERM = true, AFTER_DRAIN = false;
    bf16* O; int ldc; const float* rs;
    __device__ __forceinline__ void operator()(const f32x4 (&acc)[2][2][4][2], const Unit& u, int wr, int wc, int fr, int fq) const {
        const int row0 = u.pm * BM + wr * 64 + fr, col0 = u.pn * BM + wc * 32 + 8 * fq;
#pragma unroll
        for (int ai = 0; ai < 2; ++ai)
#pragma unroll
            for (int m = 0; m < 4; ++m) { const int r = row0 + ai * HALF + m * 16; const float s = rs[r]; bf16* rowp = O + (size_t)r * ldc + col0;
#pragma unroll
                for (int bj = 0; bj < 2; ++bj) { const f32x4 v0 = acc[ai][bj][m][0] * s, v1 = acc[ai][bj][m][1] * s;
                    v4u w; w.x = pk2(v0[0], v0[1]); w.y = pk2(v0[2], v0[3]); w.z = pk2(v1[0], v1[1]); w.w = pk2(v1[2], v1[3]);
                    *(v4u*)(rowp + bj * HALF) = w; } }
    }
};
struct EpiGlu {
    static constexpr bool PERM = true, AFTER_DRAIN = false;
    bf16* O; int ldc; const bf16* Z; int ldz; const float* bias;
    __device__ __forceinline__ void operator()(const f32x4 (&acc)[2][2][4][2], const Unit& u, int wr, int wc, int fr, int fq) const {
        const int row0 = u.pm * BM + wr * 64 + fr, col0 = u.pn * BM + wc * 32 + 8 * fq;
        f32x4 bv[2][2];
#pragma unroll
        for (int bj = 0; bj < 2; ++bj)
#pragma unroll
            for (int n = 0; n < 2; ++n) bv[bj][n] = *(const f32x4*)(bias + col0 + bj * HALF + 4 * n);
#pragma unroll
        for (int ai = 0; ai < 2; ++ai)
#pragma unroll
            for (int m = 0; m < 4; ++m) { const int r = row0 + ai * HALF + m * 16;
#pragma unroll
                for (int bj = 0; bj < 2; ++bj) { const v4u zz = *(const v4u*)(Z + (size_t)r * ldz + col0 + bj * HALF);
                    const f32x4 a0 = acc[ai][bj][m][0] + bv[bj][0], a1 = acc[ai][bj][m][1] + bv[bj][1];
                    v4u w; w.x = pk2(bflo(zz.x) * sigm(a0[0]), bfhi(zz.x) * sigm(a0[1])); w.y = pk2(bflo(zz.y) * sigm(a0[2]), bfhi(zz.y) * sigm(a0[3]));
                    w.z = pk2(bflo(zz.z) * sigm(a1[0]), bfhi(zz.z) * sigm(a1[1])); w.w = pk2(bflo(zz.w) * sigm(a1[2]), bfhi(zz.w) * sigm(a1[3]));
                    *(v4u*)(O + (size_t)r * ldc + col0 + bj * HALF) = w; } }
    }
};
struct EpiOut {
    static constexpr bool PERM = true, AFTER_DRAIN = false;
    const float* X; float* OUT; bf16* XB; float* SS;
    __device__ __forceinline__ void operator()(const f32x4 (&acc)[2][2][4][2], const Unit& u, int wr, int wc, int fr, int fq) const {
        const int row0 = u.pm * BM + wr * 64 + fr, col0 = u.pn * BM + wc * 32 + 8 * fq;
#pragma unroll
        for (int ai = 0; ai < 2; ++ai)
#pragma unroll
            for (int m = 0; m < 4; ++m) { const int r = row0 + ai * HALF + m * 16; float ss = 0.f;
#pragma unroll
                for (int bj = 0; bj < 2; ++bj) { const size_t off = (size_t)r * DM + col0 + bj * HALF;
                    const f32x4 v0 = *(const f32x4*)(X + off) + acc[ai][bj][m][0], v1 = *(const f32x4*)(X + off + 4) + acc[ai][bj][m][1];
                    *(f32x4*)(OUT + off) = v0; *(f32x4*)(OUT + off + 4) = v1;
                    v4u w; w.x = pk2(v0[0], v0[1]); w.y = pk2(v0[2], v0[3]); w.z = pk2(v1[0], v1[1]); w.w = pk2(v1[2], v1[3]);
                    *(v4u*)(XB + off) = w;
                    ss += (v0[0] * v0[0] + v0[1] * v0[1]) + (v0[2] * v0[2] + v0[3] * v0[3]) + (v1[0] * v1[0] + v1[1] * v1[1]) + (v1[2] * v1[2] + v1[3] * v1[3]); }
                ss += __shfl_xor(ss, 16); ss += __shfl_xor(ss, 32);
                if (fq == 0) SS[(size_t)r * 16 + u.pn * 4 + wc] = ss; }
    }
};
struct EpiFF1 {
    static constexpr bool PERM = true, AFTER_DRAIN = false;
    bf16* O; const float* SS;
    __device__ __forceinline__ void operator()(const f32x4 (&acc)[2][2][4][2], const Unit& u, int wr, int wc, int fr, int fq) const {
        const int row0 = u.pm * BM + wr * 64 + fr, col0 = u.pn * BM + wc * 32 + 8 * fq;
#pragma unroll
        for (int ai = 0; ai < 2; ++ai)
#pragma unroll
            for (int m = 0; m < 4; ++m) { const int r = row0 + ai * HALF + m * 16;
                const f32x4* sp = (const f32x4*)(SS + (size_t)r * 16); const f32x4 s0 = sp[0], s1 = sp[1], s2 = sp[2], s3 = sp[3];
                const float tot = ((s0[0] + s0[1]) + (s0[2] + s0[3])) + ((s1[0] + s1[1]) + (s1[2] + s1[3])) + ((s2[0] + s2[1]) + (s2[2] + s2[3])) + ((s3[0] + s3[1]) + (s3[2] + s3[3]));
                const float s = 1.0f / sqrtf(tot * (1.0f / DM) + EPS);
#pragma unroll
                for (int bj = 0; bj < 2; ++bj) { f32x4 v0 = acc[ai][bj][m][0] * s, v1 = acc[ai][bj][m][1] * s;
#pragma unroll
                    for (int e = 0; e < 4; ++e) { v0[e] = fmaxf(v0[e], 0.f); v0[e] *= v0[e]; v1[e] = fmaxf(v1[e], 0.f); v1[e] *= v1[e]; }
                    v4u w; w.x = pk2(v0[0], v0[1]); w.y = pk2(v0[2], v0[3]); w.z = pk2(v1[0], v1[1]); w.w = pk2(v1[2], v1[3]);
                    *(v4u*)(O + (size_t)r * DFF + col0 + bj * HALF) = w; } }
    }
};
struct EpiFF2 {
    static constexpr bool PERM = true, AFTER_DRAIN = false;
    float* OUT;
    __device__ __forceinline__ void operator()(const f32x4 (&acc)[2][2][4][2], const Unit& u, int wr, int wc, int fr, int fq) const {
        const int row0 = u.pm * BM + wr * 64 + fr, col0 = u.pn * BM + wc * 32 + 8 * fq;
#pragma unroll
        for (int ai = 0; ai < 2; ++ai)
#pragma unroll
            for (int m = 0; m < 4; ++m) { const int r = row0 + ai * HALF + m * 16;
#pragma unroll
                for (int bj = 0; bj < 2; ++bj) { const size_t off = (size_t)r * DM + col0 + bj * HALF;
                    const f32x4 v0 = *(const f32x4*)(OUT + off) + acc[ai][bj][m][0], v1 = *(const f32x4*)(OUT + off + 4) + acc[ai][bj][m][1];
                    *(f32x4*)(OUT + off) = v0; *(f32x4*)(OUT + off + 4) = v1; } }
    }
};

__device__ __forceinline__ void p0_transpose_item(const float* __restrict__ W, int ldw, int src_n0, int K, bf16* WT, int dst_n0, const float* kscale, LAS float* scr, int k0, int lane) {
#pragma unroll 8
    for (int i = 0; i < 32; ++i) { const int kk = 2 * i + (lane >> 5); float v = W[(size_t)(k0 + kk) * ldw + src_n0 + (lane & 31)]; if (kscale) v *= kscale[k0 + kk]; scr[kk * 33 + (lane & 31)] = v; }
    LDS_WAIT();
    const int c = lane & 7;
#pragma unroll
    for (int j = 0; j < 4; ++j) { const int n = (lane >> 3) + 8 * j; const LAS float* s = scr + (8 * c) * 33 + n;
        v4u o; o.x = pk2(s[0 * 33], s[1 * 33]); o.y = pk2(s[2 * 33], s[3 * 33]); o.z = pk2(s[4 * 33], s[5 * 33]); o.w = pk2(s[6 * 33], s[7 * 33]);
        *(v4u*)(WT + (size_t)(dst_n0 + n) * K + k0 + 8 * c) = o; }
    LDS_WAIT();
}
__device__ __forceinline__ void s5_coef(const Frame& F, int g, int p, float& lbr, float& lbi, float& cr, float& ci) {
    const float dt = expf(F.in[IN_LOGDT][g]); const float lr = F.in[IN_LAMRE][g * 64 + p], li = F.in[IN_LAMIM][g * 64 + p];
    const float a = lr * dt, th = li * dt;
    float s, c, sh, ch; sincos_acc(th, s, c); sincos_acc(0.5f * th, sh, ch);
    const float e = expf(a), em1 = expm1f(a), cm1 = -2.f * sh * sh;
    lbr = e * c; lbi = e * s;
    const float nr = em1 * c + cm1, ni = lbi;
    const float inv = 1.f / (lr * lr + li * li);
    cr = (nr * lr + ni * li) * inv; ci = (ni * lr - nr * li) * inv;
}
__device__ __forceinline__ void p0_prologue(const Frame& F) {
    LAS float* scr = (LAS float*)(F.lds + F.wave * 8704);
    LAS float* WG = (LAS float*)(F.lds + 69632);
    const float* w_in = F.in[IN_WIN]; const float* mixnw = F.in[IN_MIXNW];
    for (int idx = F.tid; idx < 8192; idx += 512) { const int k = idx >> 3, j = idx & 7; WG[j * 1024 + k] = w_in[(size_t)k * INW + 2048 + j] * mixnw[k]; }
    const int gw = F.bid * 8 + F.wave, NGW = F.G * 8;
    bf16* WIN_T = (bf16*)(F.ws + WS_WIN); bf16* WGLU_T = (bf16*)(F.ws + WS_WGLU); bf16* WOUT_T = (bf16*)(F.ws + WS_WOUT); bf16* W1_T = (bf16*)(F.ws + WS_W1); bf16* W2_T = (bf16*)(F.ws + WS_W2);
    for (int it = gw; it < 6016; it += NGW) {
        int r = it;
        if (r < 1280) { const int kb = r / 80, nb = r % 80, n0 = nb * 32; p0_transpose_item(w_in, INW, n0 < 2048 ? n0 : n0 + 8, 1024, WIN_T, n0, mixnw, scr, kb * 64, F.lane); continue; } r -= 1280;
        if (r < 128) { const int kb = r / 16, nb = r % 16; p0_transpose_item(F.in[IN_GLUW], 512, nb * 32, 512, WGLU_T, nb * 32, nullptr, scr, kb * 64, F.lane); continue; } r -= 128;
        if (r < 512) { const int kb = r / 32, nb = r % 32; p0_transpose_item(F.in[IN_WOUT], 1024, nb * 32, 1024, WOUT_T, nb * 32, nullptr, scr, kb * 64, F.lane); continue; } r -= 512;
        if (r < 2048) { const int kb = r / 128, nb = r % 128; p0_transpose_item(F.in[IN_WFF1], 4096, nb * 32, 1024, W1_T, nb * 32, F.in[IN_MLPNW], scr, kb * 64, F.lane); continue; } r -= 2048;
        { const int kb = r / 32, nb = r % 32; p0_transpose_item(F.in[IN_WFF2], 1024, nb * 32, 4096, W2_T, nb * 32, nullptr, scr, kb * 64, F.lane); }
    }
    { const int gt = F.bid * 512 + F.tid, NT = F.G * 512;
      bf16* BBAR = (bf16*)(F.ws + WS_BBAR); bf16* CM = (bf16*)(F.ws + WS_CM); f32x2v* LAMB = (f32x2v*)(F.ws + WS_LAMB);
      for (int e = gt; e < 65536; e += NT) {
          { const int g = e >> 11, r = (e >> 4) & 127, c = e & 15, p = r & 63; float lbr, lbi, cr, ci; s5_coef(F, g, p, lbr, lbi, cr, ci);
            const float br = F.in[IN_BRE][(g * 64 + p) * 16 + c], bi = F.in[IN_BIM][(g * 64 + p) * 16 + c];
            const float re = cr * br - ci * bi, im = cr * bi + ci * br; BBAR[e] = (bf16)(pk2(r < 64 ? re : im, 0.f) & 0xffffu);
            if (r < 64 && c == 0) LAMB[g * 64 + p] = (f32x2v){lbr, lbi}; }
          { const int g = e >> 11, c = (e >> 7) & 15, k = e & 127, p = k & 63;
            const float v = k < 64 ? F.in[IN_CRE][(g * 16 + c) * 64 + p] : -F.in[IN_CIM][(g * 16 + c) * 64 + p]; CM[e] = (bf16)(pk2(v, 0.f) & 0xffffu); }
      } }
    __syncthreads();
    const float* x = F.in[IN_X]; bf16* XB = (bf16*)(F.ws + WS_XB); float* R1 = (float*)(F.ws + WS_R1); float* GATES = (float*)(F.ws + WS_GATES);
    for (int m = gw; m < SEQ; m += NGW) {
        const f32x4* xr = (const f32x4*)(x + (size_t)m * DM) + F.lane;
        f32x4 v[4]; float ss = 0.f;
#pragma unroll
        for (int j = 0; j < 4; ++j) { v[j] = xr[64 * j]; ss += (v[j][0] * v[j][0] + v[j][1] * v[j][1]) + (v[j][2] * v[j][2] + v[j][3] * v[j][3]); }
        ss = wave_sum(ss); const float r = 1.0f / sqrtf(ss * (1.0f / DM) + EPS);
        v2u* o8 = (v2u*)(XB + (size_t)m * DM) + F.lane;
#pragma unroll
        for (int j = 0; j < 4; ++j) { v2u w; w.x = pk2(v[j][0], v[j][1]); w.y = pk2(v[j][2], v[j][3]); o8[64 * j] = w; }
        float gv = 0.f;
#pragma unroll
        for (int g = 0; g < 8; ++g) { float a = 0.f;
#pragma unroll
            for (int j = 0; j < 4; ++j) { const f32x4 w = *(const LAS f32x4*)(WG + g * 1024 + 256 * j + 4 * F.lane); a += (v[j][0] * w[0] + v[j][1] * w[1]) + (v[j][2] * w[2] + v[j][3] * w[3]); }
            a = wave_sum(a); if (F.lane == g) gv = a * r; }
        if (F.lane < 8) GATES[(size_t)m * 8 + F.lane] = gv;
        if (F.lane == 0) R1[m] = r;
    }
}

__device__ __forceinline__ void conv8(const Frame& F, const bf16* PROJ, int t0, int tg, int col, float scale, float (&o0)[8], float (&o1)[8]) {
    const float* cw = F.in[IN_CONVW]; const float* cb = F.in[IN_CONVB];
    float w0[4], w1[4];
#pragma unroll
    for (int j = 0; j < 4; ++j) { w0[j] = cw[j * 1024 + col]; w1[j] = cw[j * 1024 + col + 1]; }
    const float b0 = cb[col], b1 = cb[col + 1];
    float x0[11], x1[11];
#pragma unroll
    for (int i = 0; i < 11; ++i) { const int tt = t0 + 8 * tg - 3 + i; unsigned w = 0u; if (tt >= 0) w = *(const unsigned*)(PROJ + (size_t)tt * NPJ + col); x0[i] = bflo(w); x1[i] = bfhi(w); }
#pragma unroll
    for (int o = 0; o < 8; ++o) {
        float a0 = b0, a1 = b1;
#pragma unroll
        for (int j = 0; j < 4; ++j) { a0 += w0[j] * x0[o + j]; a1 += w1[j] * x1[o + j]; }
        o0[o] = a0 * sigm(a0) * scale; o1[o] = a1 * sigm(a1) * scale;
    }
}
__device__ __forceinline__ void mlstm_passA(const Frame& F, int c, int h) {
    const bf16* PROJ = (const bf16*)(F.ws + WS_PROJ); const float* GATES = (const float*)(F.ws + WS_GATES);
    LAS float* WGT = (LAS float*)(F.lds); LAS bf16* KT = (LAS bf16*)(F.lds + 1024); LAS bf16* VT = (LAS bf16*)(F.lds + 19456);
    const int t0 = c * 64, unit = h * 256 + c, tid = F.tid, lane = F.lane, wave = F.wave;
    if (wave == 0) {
        const float fp = GATES[(size_t)(t0 + lane) * 8 + 4 + h] + F.in[IN_FBIAS][h], ip = GATES[(size_t)(t0 + lane) * 8 + h] + F.in[IN_IBIAS][h];
        const float b = wave_incl_sum(logsigm(fp), lane), bl = __shfl(b, 63);
        const float g = bl - b + ip, a = wave_max(g);
        WGT[lane] = __expf(g - a);
        if (lane == 0) { ((float*)(F.ws + WS_BL))[unit] = bl; ((float*)(F.ws + WS_AC))[unit] = a; }
    }
    const int cp = tid & 63, tg = tid >> 6;
    { float o0[8], o1[8]; conv8(F, PROJ, t0, tg, 512 + h * 128 + 2 * cp, 1.0f, o0, o1);
      v4u w; w.x = pk2(o0[0], o0[1]); w.y = pk2(o0[2], o0[3]); w.z = pk2(o0[4], o0[5]); w.w = pk2(o0[6], o0[7]); *(LAS v4u*)(KT + (2 * cp) * 72 + 8 * tg) = w;
      w.x = pk2(o1[0], o1[1]); w.y = pk2(o1[2], o1[3]); w.z = pk2(o1[4], o1[5]); w.w = pk2(o1[6], o1[7]); *(LAS v4u*)(KT + (2 * cp + 1) * 72 + 8 * tg) = w; }
    __syncthreads();
    { float v0[8], v1[8];
#pragma unroll
      for (int o = 0; o < 8; ++o) { const unsigned w = *(const unsigned*)(PROJ + (size_t)(t0 + 8 * tg + o) * NPJ + 1024 + h * 128 + 2 * cp); const float g = WGT[8 * tg + o]; v0[o] = bflo(w) * g; v1[o] = bfhi(w) * g; }
      v4u w; w.x = pk2(v0[0], v0[1]); w.y = pk2(v0[2], v0[3]); w.z = pk2(v0[4], v0[5]); w.w = pk2(v0[6], v0[7]); *(LAS v4u*)(VT + (2 * cp) * 72 + 8 * tg) = w;
      w.x = pk2(v1[0], v1[1]); w.y = pk2(v1[2], v1[3]); w.z = pk2(v1[4], v1[5]); w.w = pk2(v1[6], v1[7]); *(LAS v4u*)(VT + (2 * cp + 1) * 72 + 8 * tg) = w; }
    if (tid < 128) { float a = 0.f;
#pragma unroll
        for (int i = 0; i < 8; ++i) { const v4u w = *(const LAS v4u*)(KT + tid * 72 + 8 * i);
            a += bflo(w.x) * WGT[8 * i] + bfhi(w.x) * WGT[8 * i + 1] + bflo(w.y) * WGT[8 * i + 2] + bfhi(w.y) * WGT[8 * i + 3] + bflo(w.z) * WGT[8 * i + 4] + bfhi(w.z) * WGT[8 * i + 5] + bflo(w.w) * WGT[8 * i + 6] + bfhi(w.w) * WGT[8 * i + 7]; }
        ((float*)(F.ws + WS_NLOC))[(size_t)unit * 128 + tid] = a; }
    __syncthreads();
    { const int fr = lane & 15, fq = lane >> 4, nt = wave;
      bf16x8 bfr[2];
#pragma unroll
      for (int ks = 0; ks < 2; ++ks) bfr[ks] = *(const LAS bf16x8*)(VT + (16 * nt + fr) * 72 + 8 * fq + 32 * ks);
      bf16* CL = (bf16*)(F.ws + WS_CLOC) + (size_t)unit * 16384 + (size_t)(16 * nt + fr) * 128;
#pragma unroll
      for (int mp = 0; mp < 4; ++mp) { f32x4 acc[2];
#pragma unroll
          for (int e = 0; e < 2; ++e) { const int dk = 32 * mp + 8 * (fr >> 2) + 4 * e + (fr & 3); acc[e] = (f32x4){0.f, 0.f, 0.f, 0.f};
#pragma unroll
              for (int ks = 0; ks < 2; ++ks) { const bf16x8 a = *(const LAS bf16x8*)(KT + dk * 72 + 8 * fq + 32 * ks); acc[e] = __builtin_amdgcn_mfma_f32_16x16x32_bf16(a, bfr[ks], acc[e], 0, 0, 0); } }
          v4u w; w.x = pk2(acc[0][0], acc[0][1]); w.y = pk2(acc[0][2], acc[0][3]); w.z = pk2(acc[1][0], acc[1][1]); w.w = pk2(acc[1][2], acc[1][3]);
          *(v4u*)(CL + 32 * mp + 8 * fq) = w; } }
    __syncthreads();
}
__device__ __forceinline__ void mlstm_passB(const Frame& F, int c, int h) {
    const bf16* PROJ = (const bf16*)(F.ws + WS_PROJ); const float* GATES = (const float*)(F.ws + WS_GATES);
    LAS float* BT = (LAS float*)(F.lds); LAS float* ET = BT + 64; LAS float* MT = BT + 128; LAS float* ISC = BT + 192; LAS float* DINV = BT + 256;
    LAS bf16* Q = (LAS bf16*)(F.lds + 2048); LAS bf16* KK = (LAS bf16*)(F.lds + 19456); LAS bf16* VT = (LAS bf16*)(F.lds + 36864); LAS bf16* P = (LAS bf16*)(F.lds + 55296);
    LAS float* H = (LAS float*)(F.lds + 64512);
    const int t0 = c * 64, unit = h * 256 + c, tid = F.tid, lane = F.lane, wave = F.wave, fr = lane & 15, fq = lane >> 4;
    if (wave == 0) {
        const float fp = GATES[(size_t)(t0 + lane) * 8 + 4 + h] + F.in[IN_FBIAS][h], ip = GATES[(size_t)(t0 + lane) * 8 + h] + F.in[IN_IBIAS][h];
        const float b = wave_incl_sum(logsigm(fp), lane), e = ip - b, pm = wave_incl_max(e, lane);
        const float mp = ((const float*)(F.ws + WS_MPREV))[unit];
        const float mt = b + fmaxf(mp, pm);
        BT[lane] = b; ET[lane] = e; MT[lane] = mt; ISC[lane] = __expf(b + mp - mt);
    }
    bf16x8 bc[4]; { const bf16* CP = (const bf16*)(F.ws + WS_CPREV) + (size_t)unit * 16384 + (size_t)(16 * wave + fr) * 128 + 8 * fq;
#pragma unroll
      for (int ks = 0; ks < 4; ++ks) bc[ks] = *(const bf16x8*)(CP + 32 * ks); }
    v4u owp[2]; f32x4 npv[4];
    { const int l = tid >> 3, seg = tid & 7; const bf16* op = PROJ + (size_t)(t0 + l) * NPJ + 1536 + h * 128 + 16 * seg; owp[0] = *(const v4u*)(op); owp[1] = *(const v4u*)(op + 8);
      const float* NP = (const float*)(F.ws + WS_NPREV) + (size_t)unit * 128 + 16 * seg;
#pragma unroll
      for (int i = 0; i < 4; ++i) npv[i] = *(const f32x4*)(NP + 4 * i); }
    const int cp = tid & 63, tg = tid >> 6;
    { float o0[8], o1[8]; conv8(F, PROJ, t0, tg, h * 128 + 2 * cp, 0.08838834764831845f, o0, o1);
#pragma unroll
      for (int o = 0; o < 8; ++o) *(LAS unsigned*)(Q + (8 * tg + o) * 136 + 2 * cp) = pk2(o0[o], o1[o]);
      conv8(F, PROJ, t0, tg, 512 + h * 128 + 2 * cp, 1.0f, o0, o1);
#pragma unroll
      for (int o = 0; o < 8; ++o) *(LAS unsigned*)(KK + (8 * tg + o) * 136 + 2 * cp) = pk2(o0[o], o1[o]); }
    { unsigned wv[8];
#pragma unroll
      for (int o = 0; o < 8; ++o) wv[o] = *(const unsigned*)(PROJ + (size_t)(t0 + 8 * tg + o) * NPJ + 1024 + h * 128 + 2 * cp);
      v4u w; w.x = (wv[0] & 0xffffu) | (wv[1] << 16); w.y = (wv[2] & 0xffffu) | (wv[3] << 16); w.z = (wv[4] & 0xffffu) | (wv[5] << 16); w.w = (wv[6] & 0xffffu) | (wv[7] << 16);
      *(LAS v4u*)(VT + (2 * cp) * 72 + 8 * tg) = w;
      w.x = (wv[0] >> 16) | (wv[1] & 0xffff0000u); w.y = (wv[2] >> 16) | (wv[3] & 0xffff0000u); w.z = (wv[4] >> 16) | (wv[5] & 0xffff0000u); w.w = (wv[6] >> 16) | (wv[7] & 0xffff0000u);
      *(LAS v4u*)(VT + (2 * cp + 1) * 72 + 8 * tg) = w; }
    __syncthreads();
    { const int mt_ = wave >> 1;
      bf16x8 aq[4];
#pragma unroll
      for (int ks = 0; ks < 4; ++ks) aq[ks] = *(const LAS bf16x8*)(Q + (16 * mt_ + fr) * 136 + 8 * fq + 32 * ks);
#pragma unroll
      for (int e = 0; e < 2; ++e) { const int nt = 2 * (wave & 1) + e; f32x4 acc = (f32x4){0.f, 0.f, 0.f, 0.f};
#pragma unroll
          for (int ks = 0; ks < 4; ++ks) { const bf16x8 bk = *(const LAS bf16x8*)(KK + (16 * nt + fr) * 136 + 8 * fq + 32 * ks); acc = __builtin_amdgcn_mfma_f32_16x16x32_bf16(aq[ks], bk, acc, 0, 0, 0); }
          const int s = 16 * nt + fr; const float es = ET[s];
#pragma unroll
          for (int j = 0; j < 4; ++j) { const int l = 16 * mt_ + 4 * fq + j; const float dm = (s <= l) ? __expf(BT[l] - MT[l] + es) : 0.f; P[l * 72 + s] = (bf16)(pk2(acc[j] * dm, 0.f) & 0xffffu); } } }
    __syncthreads();
    { const int l = tid >> 3, sub = tid & 7; const v4u pw = *(const LAS v4u*)(P + l * 72 + 8 * sub);
      float rs = (bflo(pw.x) + bfhi(pw.x)) + (bflo(pw.y) + bfhi(pw.y)) + (bflo(pw.z) + bfhi(pw.z)) + (bflo(pw.w) + bfhi(pw.w));
      float qn = 0.f;
#pragma unroll
      for (int i = 0; i < 2; ++i) { const v4u qw = *(const LAS v4u*)(Q + l * 136 + 16 * sub + 8 * i); const f32x4 n0 = npv[2 * i], n1 = npv[2 * i + 1];
          qn += bflo(qw.x) * n0[0] + bfhi(qw.x) * n0[1] + bflo(qw.y) * n0[2] + bfhi(qw.y) * n0[3] + bflo(qw.z) * n1[0] + bfhi(qw.z) * n1[1] + bflo(qw.w) * n1[2] + bfhi(qw.w) * n1[3]; }
      float tot = rs + ISC[l] * qn; tot += __shfl_xor(tot, 1); tot += __shfl_xor(tot, 2); tot += __shfl_xor(tot, 4);
      if (sub == 0) DINV[l] = 1.0f / fmaxf(fabsf(tot), __expf(-MT[l])); }
    __syncthreads();
    { const int nt = wave;
      bf16x8 bv[2];
#pragma unroll
      for (int ks = 0; ks < 2; ++ks) bv[ks] = *(const LAS bf16x8*)(VT + (16 * nt + fr) * 72 + 8 * fq + 32 * ks);
#pragma unroll
      for (int mt_ = 0; mt_ < 4; ++mt_) { f32x4 a1 = (f32x4){0.f, 0.f, 0.f, 0.f}, a2 = (f32x4){0.f, 0.f, 0.f, 0.f};
#pragma unroll
          for (int ks = 0; ks < 4; ++ks) { const bf16x8 aq = *(const LAS bf16x8*)(Q + (16 * mt_ + fr) * 136 + 8 * fq + 32 * ks); a1 = __builtin_amdgcn_mfma_f32_16x16x32_bf16(aq, bc[ks], a1, 0, 0, 0); }
#pragma unroll
          for (int ks = 0; ks < 2; ++ks) { const bf16x8 ap = *(const LAS bf16x8*)(P + (16 * mt_ + fr) * 72 + 8 * fq + 32 * ks); a2 = __builtin_amdgcn_mfma_f32_16x16x32_bf16(ap, bv[ks], a2, 0, 0, 0); }
#pragma unroll
          for (int j = 0; j < 4; ++j) { const int l = 16 * mt_ + 4 * fq + j; H[l * 132 + 16 * nt + fr] = (ISC[l] * a1[j] + a2[j]) * DINV[l]; } } }
    __syncthreads();
    { const int l = tid >> 3, seg = tid & 7; float v[16]; float s = 0.f;
#pragma unroll
      for (int i = 0; i < 4; ++i) { const f32x4 t = *(const LAS f32x4*)(H + l * 132 + 16 * seg + 4 * i); v[4 * i] = t[0]; v[4 * i + 1] = t[1]; v[4 * i + 2] = t[2]; v[4 * i + 3] = t[3]; s += (t[0] + t[1]) + (t[2] + t[3]); }
      s += __shfl_xor(s, 1); s += __shfl_xor(s, 2); s += __shfl_xor(s, 4); const float mu = s * (1.0f / 128.0f); float q = 0.f;
#pragma unroll
      for (int i = 0; i < 16; ++i) { v[i] -= mu; q += v[i] * v[i]; }
      q += __shfl_xor(q, 1); q += __shfl_xor(q, 2); q += __shfl_xor(q, 4); const float rstd = 1.0f / sqrtf(q * (1.0f / 128.0f) + EPS);
      const int col = h * 128 + 16 * seg; const float* nw = F.in[IN_MNW] + col;
      bf16* mo = (bf16*)(F.ws + WS_MIXED) + (size_t)(t0 + l) * DM + col;
#pragma unroll
      for (int i = 0; i < 2; ++i) { const v4u ow = owp[i]; const f32x4 w0 = *(const f32x4*)(nw + 8 * i), w1 = *(const f32x4*)(nw + 8 * i + 4); const float* vv = v + 8 * i;
          v4u w; w.x = pk2(vv[0] * rstd * w0[0] * sigm(bflo(ow.x)), vv[1] * rstd * w0[1] * sigm(bfhi(ow.x))); w.y = pk2(vv[2] * rstd * w0[2] * sigm(bflo(ow.y)), vv[3] * rstd * w0[3] * sigm(bfhi(ow.y)));
          w.z = pk2(vv[4] * rstd * w1[0] * sigm(bflo(ow.z)), vv[5] * rstd * w1[1] * sigm(bfhi(ow.z))); w.w = pk2(vv[6] * rstd * w1[2] * sigm(bflo(ow.w)), vv[7] * rstd * w1[3] * sigm(bfhi(ow.w)));
          *(v4u*)(mo + 8 * i) = w; } }
    __syncthreads();
}

template <bool PASS2> __device__ __forceinline__ void s5_unit(const Frame& F, int sc, int go) {
    const bf16* PROJ = (const bf16*)(F.ws + WS_PROJ);
    const int lane = F.lane, wave = F.wave, fr = lane & 15, fq = lane >> 4, g = go * 8 + wave, p = lane;
    LAS float* BU = (LAS float*)(F.lds + wave * 15360); LAS bf16* XT = (LAS bf16*)(F.lds + wave * 15360 + 10240);
    const f32x2v lam = ((const f32x2v*)(F.ws + WS_LAMB))[g * 64 + p]; const float lr = lam[0], li = lam[1];
    float xr = 0.f, xi = 0.f;
    if (PASS2) { const f32x2v x0 = ((const f32x2v*)(F.ws + WS_XCARRY))[(size_t)sc * 2048 + g * 64 + p]; xr = x0[0]; xi = x0[1]; }
    const bf16x8 zero8 = (bf16x8){0, 0, 0, 0, 0, 0, 0, 0};
    bf16x8 abb[8];
#pragma unroll
    for (int mt = 0; mt < 8; ++mt) { abb[mt] = zero8; if (fq < 2) abb[mt] = *(const bf16x8*)((const bf16*)(F.ws + WS_BBAR) + (size_t)(g * 128 + 16 * mt + fr) * 16 + 8 * fq); }
    bf16x8 acm[4]; float dd[4];
    if (PASS2) {
#pragma unroll
        for (int ks = 0; ks < 4; ++ks) acm[ks] = *(const bf16x8*)((const bf16*)(F.ws + WS_CM) + (size_t)(g * 16 + fr) * 128 + 8 * fq + 32 * ks);
#pragma unroll
        for (int j = 0; j < 4; ++j) dd[j] = F.in[IN_SSMD][g * 16 + 4 * fq + j];
    }
    const bf16* ubase = PROJ + (size_t)(sc * 256 + fr) * NPJ + 2048 + g * 16;
    bf16x8 bu_n = zero8; if (fq < 2) bu_n = *(const bf16x8*)(ubase + 8 * fq);
    v2u uw_n = (v2u){0u, 0u}; if (PASS2) uw_n = *(const v2u*)(ubase + 4 * fq);
    for (int st = 0; st < 16; ++st) {
        const int tb = sc * 256 + st * 16;
        const bf16x8 bu = bu_n; const v2u uw = uw_n;
        if (st + 1 < 16) { if (fq < 2) bu_n = *(const bf16x8*)(ubase + (size_t)(st + 1) * 16 * NPJ + 8 * fq); if (PASS2) uw_n = *(const v2u*)(ubase + (size_t)(st + 1) * 16 * NPJ + 4 * fq); }
#pragma unroll
        for (int mt = 0; mt < 8; ++mt) { f32x4 acc = __builtin_amdgcn_mfma_f32_16x16x32_bf16(abb[mt], bu, (f32x4){0.f, 0.f, 0.f, 0.f}, 0, 0, 0);
#pragma unroll
            for (int j = 0; j < 4; ++j) BU[(16 * mt + 4 * fq + j) * 20 + fr] = acc[j]; }
        LDS_WAIT();
        float re[16], im[16];
#pragma unroll
        for (int i = 0; i < 4; ++i) { const f32x4 a = *(const LAS f32x4*)(BU + p * 20 + 4 * i), b = *(const LAS f32x4*)(BU + (64 + p) * 20 + 4 * i);
            re[4 * i] = a[0]; re[4 * i + 1] = a[1]; re[4 * i + 2] = a[2]; re[4 * i + 3] = a[3]; im[4 * i] = b[0]; im[4 * i + 1] = b[1]; im[4 * i + 2] = b[2]; im[4 * i + 3] = b[3]; }
#pragma unroll
        for (int n = 0; n < 16; ++n) { const float nr = fmaf(lr, xr, fmaf(-li, xi, re[n])), ni = fmaf(lr, xi, fmaf(li, xr, im[n])); xr = nr; xi = ni;
            if (PASS2) { XT[n * 136 + p] = (bf16)(pk2(xr, 0.f) & 0xffffu); XT[n * 136 + 64 + p] = (bf16)(pk2(xi, 0.f) & 0xffffu); } }
        if (PASS2) {
            LDS_WAIT();
            f32x4 ay = (f32x4){0.f, 0.f, 0.f, 0.f};
#pragma unroll
            for (int ks = 0; ks < 4; ++ks) { const bf16x8 bx = *(const LAS bf16x8*)(XT + fr * 136 + 8 * fq + 32 * ks); ay = __builtin_amdgcn_mfma_f32_16x16x32_bf16(acm[ks], bx, ay, 0, 0, 0); }
            const float y0 = ay[0] + dd[0] * bflo(uw.x), y1 = ay[1] + dd[1] * bfhi(uw.x), y2 = ay[2] + dd[2] * bflo(uw.y), y3 = ay[3] + dd[3] * bfhi(uw.y);
            v2u zw; zw.x = pk2(gelu_tanh(y0), gelu_tanh(y1)); zw.y = pk2(gelu_tanh(y2), gelu_tanh(y3));
            *(v2u*)((bf16*)(F.ws + WS_Z) + (size_t)(tb + fr) * 512 + g * 16 + 4 * fq) = zw;
            LDS_WAIT();
        }
    }
    if (!PASS2) ((f32x2v*)(F.ws + WS_XEND))[(size_t)sc * 2048 + g * 64 + p] = (f32x2v){xr, xi};
    __syncthreads();
}

__device__ __forceinline__ void p3_scan(const Frame& F) {
    LAS f32x2v* SOSN = (LAS f32x2v*)(F.lds); LAS f32x2v* E = (LAS f32x2v*)(F.lds + 8192); LAS float* PSEG = (LAS float*)(F.lds + 12288); LAS float* EN = (LAS float*)(F.lds + 12544);
    const int lane = F.lane, wave = F.wave, tid = F.tid;
    if (wave < 4) {
        const int h = wave;
        const f32x4 bl = *(const f32x4*)((const float*)(F.ws + WS_BL) + h * 256 + 4 * lane), a = *(const f32x4*)((const float*)(F.ws + WS_AC) + h * 256 + 4 * lane);
        const float s0 = bl[0], s1 = s0 + bl[1], s2 = s1 + bl[2], s3 = s2 + bl[3];
        const float incl = wave_incl_sum(s3, lane); float off = __shfl_up(incl, 1); if (lane == 0) off = 0.f;
        const float IB[4] = {off + s0, off + s1, off + s2, off + s3}, B[4] = {off, off + s0, off + s1, off + s2};
        const float v0 = a[0] - IB[0], v1 = a[1] - IB[1], v2 = a[2] - IB[2], v3 = a[3] - IB[3];
        const float pm0 = v0, pm1 = fmaxf(pm0, v1), pm2 = fmaxf(pm1, v2), pm3 = fmaxf(pm2, v3);
        const float inclm = wave_incl_max(pm3, lane); float exm = __shfl_up(inclm, 1); if (lane == 0) exm = -INFINITY;
        const float base = fmaxf(0.f, exm);
        const float Mex[4] = {base, fmaxf(base, pm0), fmaxf(base, pm1), fmaxf(base, pm2)}, val[4] = {v0, v1, v2, v3};
        float prod = 1.f;
#pragma unroll
        for (int k = 0; k < 4; ++k) { const float mprev = Mex[k] + B[k], mnew = fmaxf(Mex[k], val[k]) + IB[k];
            const float so = __expf(bl[k] + mprev - mnew), sn = __expf(a[k] - mnew); prod *= so;
            SOSN[h * 256 + 4 * lane + k] = (f32x2v){so, sn};
            if (F.bid == 0) ((float*)(F.ws + WS_MPREV))[h * 256 + 4 * lane + k] = mprev; }
        prod *= __shfl_xor(prod, 1); prod *= __shfl_xor(prod, 2); prod *= __shfl_xor(prod, 4); prod *= __shfl_xor(prod, 8);
        if ((lane & 15) == 0) PSEG[h * 4 + (lane >> 4)] = prod;
    }
    __syncthreads();
    for (int task = F.bid; task < 264; task += F.G) {
        if (task < 256) {
            const int h = task >> 6, seg = wave >> 1, half = wave & 1, dw = (task & 63) * 128 + half * 64 + lane;
            const unsigned* src = (const unsigned*)(F.ws + WS_CLOC) + (size_t)(h * 256 + seg * 64) * 8192 + dw;
            unsigned* dst = (unsigned*)(F.ws + WS_CPREV) + (size_t)(h * 256 + seg * 64) * 8192 + dw;
            unsigned raw[64];
#pragma unroll
            for (int i = 0; i < 64; ++i) raw[i] = src[(size_t)i * 8192];
            float a0 = 0.f, a1 = 0.f;
#pragma unroll
            for (int i = 0; i < 64; ++i) { const f32x2v ss = SOSN[h * 256 + seg * 64 + i]; a0 = ss[0] * a0 + ss[1] * bflo(raw[i]); a1 = ss[0] * a1 + ss[1] * bfhi(raw[i]); }
            E[seg * 128 + half * 64 + lane] = (f32x2v){a0, a1};
            __syncthreads();
            float x0 = 0.f, x1 = 0.f;
            for (int s = 0; s < seg; ++s) { const float ps = PSEG[h * 4 + s]; const f32x2v e = E[s * 128 + half * 64 + lane]; x0 = ps * x0 + e[0]; x1 = ps * x1 + e[1]; }
#pragma unroll
            for (int i = 0; i < 64; ++i) { dst[(size_t)i * 8192] = pk2(x0, x1); const f32x2v ss = SOSN[h * 256 + seg * 64 + i]; x0 = ss[0] * x0 + ss[1] * bflo(raw[i]); x1 = ss[0] * x1 + ss[1] * bfhi(raw[i]); }
            __syncthreads();
        } else if (task < 260) {
            const int h = task - 256, seg = tid >> 7, dk = tid & 127;
            const float* src = (const float*)(F.ws + WS_NLOC) + (size_t)(h * 256 + seg * 64) * 128 + dk; float* dst = (float*)(F.ws + WS_NPREV) + (size_t)(h * 256 + seg * 64) * 128 + dk;
            float raw[64];
#pragma unroll
            for (int i = 0; i < 64; ++i) raw[i] = src[i * 128];
            float a0 = 0.f;
#pragma unroll
            for (int i = 0; i < 64; ++i) { const f32x2v ss = SOSN[h * 256 + seg * 64 + i]; a0 = ss[0] * a0 + ss[1] * raw[i]; }
            EN[seg * 128 + dk] = a0;
            __syncthreads();
            float x0 = 0.f;
            for (int s = 0; s < seg; ++s) x0 = PSEG[h * 4 + s] * x0 + EN[s * 128 + dk];
#pragma unroll
            for (int i = 0; i < 64; ++i) { dst[i * 128] = x0; const f32x2v ss = SOSN[h * 256 + seg * 64 + i]; x0 = ss[0] * x0 + ss[1] * raw[i]; }
            __syncthreads();
        } else {
            const int ch = (task - 260) * 512 + tid;
            f32x2v lam = ((const f32x2v*)(F.ws + WS_LAMB))[ch];
#pragma unroll
            for (int i = 0; i < 8; ++i) lam = (f32x2v){lam[0] * lam[0] - lam[1] * lam[1], 2.f * lam[0] * lam[1]};
            const f32x2v* src = (const f32x2v*)(F.ws + WS_XEND) + ch; f32x2v* dst = (f32x2v*)(F.ws + WS_XCARRY) + ch;
            float xr = 0.f, xi = 0.f;
#pragma unroll 16
            for (int sc = 0; sc < 64; ++sc) { dst[(size_t)sc * 2048] = (f32x2v){xr, xi}; const f32x2v e = src[(size_t)sc * 2048];
                const float nr = lam[0] * xr - lam[1] * xi + e[0], ni = lam[0] * xi + lam[1] * xr + e[1]; xr = nr; xi = ni; }
        }
    }
}

__device__ __forceinline__ void p9_final(const Frame& F) {
    const int gw = F.bid * 8 + F.wave, NGW = F.G * 8; const float* fw = F.in[IN_FINW];
    f32x4 wv[4];
#pragma unroll
    for (int j = 0; j < 4; ++j) wv[j] = *((const f32x4*)fw + F.lane + 64 * j);
    for (int m = gw; m < SEQ; m += NGW) {
        f32x4* xr = (f32x4*)(F.out + (size_t)m * DM) + F.lane;
        f32x4 v[4]; float ss = 0.f;
#pragma unroll
        for (int j = 0; j < 4; ++j) { v[j] = xr[64 * j]; ss += (v[j][0] * v[j][0] + v[j][1] * v[j][1]) + (v[j][2] * v[j][2] + v[j][3] * v[j][3]); }
        ss = wave_sum(ss); const float r = 1.0f / sqrtf(ss * (1.0f / DM) + EPS);
#pragma unroll
        for (int j = 0; j < 4; ++j) xr[64 * j] = v[j] * r * wv[j];
    }
}

__global__ void __launch_bounds__(512, 2) hymba_fwd(Args args) {
    extern __shared__ __attribute__((aligned(16))) unsigned char lds_raw[];
    cg::grid_group grid = cg::this_grid();
    Frame F;
    F.lds = (LAS unsigned char*)lds_raw; F.ws = args.ws; F.tid = threadIdx.x; F.lane = F.tid & 63; F.wave = __builtin_amdgcn_readfirstlane(F.tid >> 6); F.G = gridDim.x; F.bid = blockIdx.x;
#pragma unroll
    for (int i = 0; i < 23; ++i) F.in[i] = args.in[i];
    F.out = args.out;
    const int lo = args.ph_lo, hi = args.ph_hi;
    volatile LAS unsigned* MISC = (volatile LAS unsigned*)(F.lds + 131072);
    if (F.tid < 16) MISC[F.tid] = 0u;
    __syncthreads();
    XcdBarrier bar; bar.bar = (unsigned*)(F.ws + WS_CTL); bar.x = 0; bar.st = MISC;
    if (hi - lo > 1) bar = xcd_barrier_post((unsigned*)(F.ws + WS_CTL), MISC);
    if (lo < 0) grid.sync();
#define IN(k) (lo <= (k) && (k) < hi)
#ifndef REP_PHASE
#define REP_PHASE -1
#endif
#ifndef SYNC_REP
#define SYNC_REP 1
#endif
#define SEAM(k) do { if (IN(k) && IN((k) + 1)) { for (int sr_ = 0; sr_ < SYNC_REP; ++sr_) xcd_barrier(bar); } } while (0)
#define REPS(k) for (int rep_ = 0; rep_ < ((k) == REP_PHASE ? 2 : 1); ++rep_)
#define REPSYNC(k) do { if ((k) == REP_PHASE && rep_ == 0) xcd_barrier(bar); } while (0)
    bf16* XB = (bf16*)(F.ws + WS_XB); bf16* PROJ = (bf16*)(F.ws + WS_PROJ); bf16* MIXED = (bf16*)(F.ws + WS_MIXED); bf16* Z = (bf16*)(F.ws + WS_Z); bf16* AB = (bf16*)(F.ws + WS_A);
    float* SS1 = (float*)(F.ws + WS_SS1);
    if (IN(0)) REPS(0) { p0_prologue(F); REPSYNC(0); }
    SEAM(0);
    if (IN(1)) REPS(1) { pg8::Gemm g{XB, (const bf16*)(F.ws + WS_WIN), SEQ, NPJ, DM}; pg8::StaticOrder S; S.init(SEQ, NPJ, F.G, F.bid);
        EpiProj E{PROJ, NPJ, (const float*)(F.ws + WS_R1)};
        pg8::gemm_phase<EpiProj, pg8::StaticOrder, true, true>(F.lds, g, S, E); REPSYNC(1); }
    SEAM(1);
    if (IN(2)) REPS(2) { for (int u = F.bid; u < 1024; u += F.G) mlstm_passA(F, u >> 2, u & 3);
        for (int u = F.bid; u < 256; u += F.G) s5_unit<false>(F, u >> 2, u & 3); REPSYNC(2); }
    SEAM(2);
    if (IN(3)) REPS(3) { p3_scan(F); REPSYNC(3); }
    SEAM(3);
    if (IN(4)) REPS(4) { for (int u = F.bid; u < 1024; u += F.G) mlstm_passB(F, u >> 2, u & 3);
        for (int u = F.bid; u < 256; u += F.G) s5_unit<true>(F, u >> 2, u & 3); REPSYNC(4); }
    SEAM(4);
    if (IN(5)) REPS(5) { pg8::Gemm g{Z, (const bf16*)(F.ws + WS_WGLU), SEQ, 512, 512}; pg8::StaticOrder S; S.init(SEQ, 512, F.G, F.bid);
        EpiGlu E{MIXED + 512, DM, Z, 512, F.in[IN_GLUB]};
        pg8::gemm_phase<EpiGlu, pg8::StaticOrder, true, true>(F.lds, g, S, E); REPSYNC(5); }
    SEAM(5);
    if (IN(6)) REPS(6) { pg8::Gemm g{MIXED, (const bf16*)(F.ws + WS_WOUT), SEQ, DM, DM}; pg8::StaticOrder S; S.init(SEQ, DM, F.G, F.bid);
        EpiOut E{F.in[IN_X], F.out, XB, SS1};
        pg8::gemm_phase<EpiOut, pg8::StaticOrder, true, true>(F.lds, g, S, E); REPSYNC(6); }
    SEAM(6);
    if (IN(7)) REPS(7) { pg8::Gemm g{XB, (const bf16*)(F.ws + WS_W1), SEQ, DFF, DM}; pg8::StaticOrder S; S.init(SEQ, DFF, F.G, F.bid);
        EpiFF1 E{AB, SS1};
        pg8::gemm_phase<EpiFF1, pg8::StaticOrder, true, true>(F.lds, g, S, E); REPSYNC(7); }
    SEAM(7);
    if (IN(8)) { pg8::Gemm g{AB, (const bf16*)(F.ws + WS_W2), SEQ, DM, DFF}; pg8::StaticOrder S; S.init(SEQ, DM, F.G, F.bid);
        EpiFF2 E{F.out};
        pg8::gemm_phase<EpiFF2, pg8::StaticOrder, true, true>(F.lds, g, S, E); }
    SEAM(8);
    if (IN(9)) { p9_final(F); }
#undef IN
#undef SEAM
}

extern "C" void kernel_launch(void* const* d_in, const int* in_sizes, int n_in, void* d_out, int out_size, void* d_ws, size_t ws_size, hipStream_t stream) {
    static int grid = 0;
    if (grid == 0) {
        if (n_in != 23 || out_size != SEQ * DM || ws_size < WS_END) { fprintf(stderr, "kernel_launch: unexpected shapes (n_in %d out %d ws %zu)\n", n_in, out_size, ws_size); grid = -1; return; }
        int dev = 0, cus = 0, per_cu = 0;
        hipGetDevice(&dev); hipDeviceGetAttribute(&cus, hipDeviceAttributeMultiprocessorCount, dev);
        if (hipFuncSetAttribute((const void*)hymba_fwd, hipFuncAttributeMaxDynamicSharedMemorySize, LDS_BYTES) != hipSuccess) { fprintf(stderr, "kernel_launch: hipFuncSetAttribute failed\n"); grid = -1; return; }
        if (hipOccupancyMaxActiveBlocksPerMultiprocessor(&per_cu, (const void*)hymba_fwd, 512, LDS_BYTES) != hipSuccess || per_cu < 1) { fprintf(stderr, "kernel_launch: occupancy query says %d\n", per_cu); per_cu = 1; }
        (void)hipGetLastError();
        grid = cus * 1;
        if (grid > 256) grid = 256;
    }
    if (grid < 0) return;
    Args a{};
#if MK_N_LAUNCHES == 1
    if (hipMemsetAsync((char*)d_ws + WS_CTL, 0, CTL_ZERO_BYTES, stream) != hipSuccess) { fprintf(stderr, "kernel_launch: memset failed\n"); return; }
#endif
    for (int i = 0; i < 23; ++i) a.in[i] = (const float*)d_in[i];
    a.out = (float*)d_out; a.ws = (unsigned char*)d_ws;
#if MK_N_LAUNCHES == 1
    a.ph_lo = 0; a.ph_hi = NPHASE;
    void* kargs[] = {&a};
    hipError_t e = hipLaunchCooperativeKernel((const void*)hymba_fwd, dim3(grid), dim3(512), kargs, LDS_BYTES, stream);
    if (e != hipSuccess) fprintf(stderr, "cooperative launch failed: %s (grid %d)\n", hipGetErrorString(e), grid);
#else
    for (int k = 0; k < NPHASE; ++k) { a.ph_lo = k; a.ph_hi = k + 1; hipLaunchKernelGGL(hymba_fwd, dim3(grid), dim3(512), LDS_BYTES, stream, a); }
#endif
}
```
